# Optimizing an MI355X kernel written in HIP

```python
import jax, jax.numpy as jnp
from jax import lax
import numpy as np

D_MODEL = 1024
BATCH = 4
SEQ = 4096
DEPTH = 2

GRID_W = 64
CTX_LEN = 256
EPS = 1e-6

F_GROUPS = 4
F_GDIM = 64
F_WIDTH = F_GROUPS * F_GDIM
NA_HEADS = 8
HEAD_DIM = 64
NA_WIDTH = NA_HEADS * HEAD_DIM
NA_WIN_R = 8
NA_WIN_C = 16
ATTN_SCALE = HEAD_DIM ** -0.5
ROPE_BASE = 10000.0
ROPE_HALF = HEAD_DIM // 2
ROPE_PER_AXIS = HEAD_DIM // 4
CONV_WIDTH = 256
CONV_K = 3
N_BRANCH = 3
COL_F = 0
COL_Q = COL_F + F_WIDTH
COL_K = COL_Q + NA_WIDTH
COL_V = COL_K + NA_WIDTH
COL_CX = COL_V + NA_WIDTH
COL_CB = COL_CX + CONV_WIDTH
COL_CC = COL_CB + CONV_WIDTH
COL_G = COL_CC + CONV_WIDTH
IN_WIDTH = COL_G + N_BRANCH * D_MODEL
N_EXPERTS = 16
N_GROUPS = 4
EXPERTS_PER_GROUP = N_EXPERTS // N_GROUPS
TOPK_GROUPS = 1
TOP_K = 2
D_EXPERT = 512
MOE_BLOCK = 128

kernel_name = 'hybrid_fourier_na_conv_grouped_moe_dit'


def rmsnorm(x, g):
    xf = x.astype(jnp.float32)
    y = xf * lax.rsqrt(jnp.mean(xf * xf, axis=-1, keepdims=True) + EPS)
    return (y * g.astype(jnp.float32)).astype(x.dtype)


def modulate(h, shift, scale):
    return h * (1.0 + scale) + shift


def axial_rope_tables(L, dtype):
    t = jnp.arange(L)
    row = (t // GRID_W).astype(jnp.float32)
    col = (t % GRID_W).astype(jnp.float32)
    inv = jnp.power(ROPE_BASE, -jnp.arange(ROPE_PER_AXIS, dtype=jnp.float32) / ROPE_PER_AXIS)
    ang = jnp.concatenate([row[:, None] * inv, col[:, None] * inv], axis=-1)
    return jnp.cos(ang)[:, None, :].astype(dtype), jnp.sin(ang)[:, None, :].astype(dtype)


def apply_rope(x, cos, sin):
    x1, x2 = x[..., :ROPE_HALF], x[..., ROPE_HALF:]
    return jnp.concatenate([x1 * cos - x2 * sin, x2 * cos + x1 * sin], axis=-1)


def q_heads(pq, qn_g):
    bsz, L, _ = pq.shape
    return rmsnorm(pq.reshape(bsz, L, NA_HEADS, HEAD_DIM), qn_g)


def kv_heads(pkv, kn_g):
    bsz, L, _ = pkv.shape
    k = rmsnorm(pkv[..., :NA_WIDTH].reshape(bsz, L, NA_HEADS, HEAD_DIM), kn_g)
    v = pkv[..., NA_WIDTH:].reshape(bsz, L, NA_HEADS, HEAD_DIM)
    return k, v


def fourier_mix(u):
    bsz, L, _ = u.shape
    ug = u.reshape(bsz, L, F_GROUPS, F_GDIM).astype(jnp.float32)
    f = jnp.fft.fft2(ug, axes=(1, 3), norm='ortho').real
    return f.reshape(bsz, L, F_WIDTH).astype(u.dtype)


def short_conv(xc, bg, cg, conv_w):
    u = cg * xc
    up = jnp.pad(u, ((0, 0), (1, 1), (0, 0)))
    y = conv_w[0] * up[:, :-2] + conv_w[1] * up[:, 1:-1] + conv_w[2] * up[:, 2:]
    return bg * y


def context_attention(q, k, v):
    bsz, L = q.shape[:2]
    s = jnp.einsum('bqhd,bkhd->bhqk', q, k).astype(jnp.float32) * ATTN_SCALE
    p = jax.nn.softmax(s, axis=-1).astype(v.dtype)
    return jnp.einsum('bhqk,bkhd->bqhd', p, v).reshape(bsz, L, NA_WIDTH)


def neighbourhood_attention(q, k, v, k_ctx, v_ctx, rpb):
    bsz, L, H, Dh = q.shape
    rows = L // GRID_W
    wr = min(NA_WIN_R, rows)
    qg = q.reshape(bsz, rows, GRID_W, H, Dh)
    kg = k.reshape(bsz, rows, GRID_W, H, Dh)
    vg = v.reshape(bsz, rows, GRID_W, H, Dh)
    r = jnp.arange(rows)
    row_start = jnp.clip(r - wr // 2, 0, rows - wr)
    row_idx = row_start[:, None] + jnp.arange(wr)[None, :]
    kb = kg[:, row_idx]
    vb = vg[:, row_idx]
    col = jnp.arange(GRID_W)
    col_start = jnp.clip(col - NA_WIN_C // 2, 0, GRID_W - NA_WIN_C)
    col_mask = (col[None, :] >= col_start[:, None]) & (col[None, :] < col_start[:, None] + NA_WIN_C)
    dr = row_idx - r[:, None] + (NA_WIN_R - 1)
    dc = jnp.clip(col[None, :] - col[:, None] + (NA_WIN_C - 1), 0, 2 * NA_WIN_C - 2)
    bias = rpb[:, dr][:, :, :, dc].transpose(1, 3, 0, 2, 4)
    s_loc = jnp.einsum('brqhd,brkwhd->brqhkw', qg, kb).astype(jnp.float32) * ATTN_SCALE
    s_loc = s_loc + bias.astype(jnp.float32)
    s_loc = jnp.where(col_mask[:, None, None, :], s_loc, -jnp.inf)
    s_ctx = jnp.einsum('brqhd,bkhd->brqhk', qg, k_ctx).astype(jnp.float32) * ATTN_SCALE
    n_loc = wr * GRID_W
    s = jnp.concatenate([s_loc.reshape(bsz, rows, GRID_W, H, n_loc), s_ctx], axis=-1)
    p = jax.nn.softmax(s, axis=-1).astype(v.dtype)
    p_loc = p[..., :n_loc].reshape(bsz, rows, GRID_W, H, wr, GRID_W)
    p_ctx = p[..., n_loc:]
    out = (jnp.einsum('brqhkw,brkwhd->brqhd', p_loc, vb)
           + jnp.einsum('brqhk,bkhd->brqhd', p_ctx, v_ctx))
    return out.reshape(bsz, L, NA_WIDTH)


def merge_branches(P, attn, w_f, w_na, w_cv, conv_w, w_o):
    f = fourier_mix(P[..., COL_F:COL_Q])
    y_cv = short_conv(P[..., COL_CX:COL_CB], P[..., COL_CB:COL_CC], P[..., COL_CC:COL_G], conv_w)
    g = jax.nn.sigmoid(P[..., COL_G:])
    g_f = g[..., :D_MODEL]
    g_na = g[..., D_MODEL:2 * D_MODEL]
    g_cv = g[..., 2 * D_MODEL:]
    merged = g_f * (f @ w_f) + g_na * (attn @ w_na) + g_cv * (y_cv @ w_cv)
    return merged @ w_o


def route(h, router_w, router_b):
    n = h.shape[0]
    s = jax.nn.sigmoid((h @ router_w).astype(jnp.float32))
    sb = s + router_b.astype(jnp.float32)
    gscore = lax.top_k(sb.reshape(n, N_GROUPS, EXPERTS_PER_GROUP), 2)[0].sum(-1)
    _, gidx = lax.top_k(gscore, TOPK_GROUPS)
    gmask = jnp.any(gidx[..., None] == jnp.arange(N_GROUPS), axis=1)
    emask = jnp.repeat(gmask, EXPERTS_PER_GROUP, axis=-1)
    _, eidx = lax.top_k(jnp.where(emask, sb, -jnp.inf), TOP_K)
    w = jnp.take_along_axis(s, eidx, axis=-1)
    w = w / jnp.sum(w, axis=-1, keepdims=True)
    return eidx, w


def moe_ffn(h, router_w, router_b, w1, w3, w2):
    n, d = h.shape
    eidx, wts = route(h, router_w, router_b)
    a = n * TOP_K
    flat_e = eidx.reshape(a)
    flat_t = jnp.repeat(jnp.arange(n, dtype=jnp.int32), TOP_K)
    flat_w = wts.reshape(a)
    order = jnp.argsort(flat_e)
    e_s, t_s, w_s = flat_e[order], flat_t[order], flat_w[order]
    counts = jnp.bincount(flat_e, length=N_EXPERTS)
    starts = jnp.cumsum(counts) - counts
    padded = (counts + MOE_BLOCK - 1) // MOE_BLOCK * MOE_BLOCK
    pends = jnp.cumsum(padded)
    pstarts = pends - padded
    dest = pstarts[e_s] + (jnp.arange(a) - starts[e_s])
    n_blk = (a + N_EXPERTS * (MOE_BLOCK - 1) + MOE_BLOCK - 1) // MOE_BLOCK
    p_len = n_blk * MOE_BLOCK
    tok_buf = jnp.full((p_len,), n, dtype=jnp.int32).at[dest].set(t_s)
    w_buf = jnp.zeros((p_len,), h.dtype).at[dest].set(w_s.astype(h.dtype))
    blk_e = jnp.minimum(jnp.searchsorted(pends, jnp.arange(n_blk) * MOE_BLOCK, side='right'), N_EXPERTS - 1)
    h_pad = jnp.concatenate([h, jnp.zeros((1, d), h.dtype)], axis=0)
    xb = h_pad[tok_buf].reshape(n_blk, MOE_BLOCK, d)

    def expert_block(args):
        xblk, e = args
        return (jax.nn.silu(xblk @ w1[e]) * (xblk @ w3[e])) @ w2[e]

    yb = lax.map(expert_block, (xb, blk_e)).reshape(p_len, d)
    out = jnp.zeros((n + 1, d), h.dtype).at[tok_buf].add(yb * w_buf[:, None])
    return out[:n]


def setup_inputs(seed: int = 0) -> dict:
    key = jax.random.key(seed)
    ks = jax.random.split(key, 24)
    D = D_MODEL

    def nrm(k, shape, scale):
        return jax.random.normal(k, shape, jnp.float32) * scale

    return {
        'x': nrm(ks[0], (BATCH, SEQ, D), 1.0),
        'c': nrm(ks[1], (BATCH, D), 1.0),
        'ctx': nrm(ks[2], (BATCH, CTX_LEN, D), 1.0),
        'c_ctx': nrm(ks[3], (D,), 1.0),
        'ada_w': nrm(ks[4], (DEPTH, D, 6 * D), 0.5 * D ** -0.5),
        'ada_b': nrm(ks[5], (DEPTH, 6 * D), 0.02),
        'norm1_g': 1.0 + nrm(ks[6], (DEPTH, D), 0.05),
        'w_in': nrm(ks[7], (DEPTH, D, IN_WIDTH), D ** -0.5),
        'qn_g': 1.0 + nrm(ks[8], (DEPTH, HEAD_DIM), 0.05),
        'kn_g': 1.0 + nrm(ks[9], (DEPTH, HEAD_DIM), 0.05),
        'rpb': nrm(ks[10], (DEPTH, NA_HEADS, 2 * NA_WIN_R - 1, 2 * NA_WIN_C - 1), 0.2),
        'conv_w': nrm(ks[11], (DEPTH, CONV_K, CONV_WIDTH), CONV_K ** -0.5),
        'w_f': nrm(ks[12], (DEPTH, F_WIDTH, D), F_WIDTH ** -0.5),
        'w_na': nrm(ks[13], (DEPTH, NA_WIDTH, D), NA_WIDTH ** -0.5),
        'w_cv': nrm(ks[14], (DEPTH, CONV_WIDTH, D), CONV_WIDTH ** -0.5),
        'w_o': nrm(ks[15], (DEPTH, D, D), D ** -0.5),
        'norm2_g': 1.0 + nrm(ks[16], (DEPTH, D), 0.05),
        'router_w': nrm(ks[17], (D, N_EXPERTS), D ** -0.5),
        'router_b': nrm(ks[18], (N_EXPERTS,), 0.01),
        'w1': nrm(ks[19], (DEPTH, N_EXPERTS, D, D_EXPERT), D ** -0.5),
        'w3': nrm(ks[20], (DEPTH, N_EXPERTS, D, D_EXPERT), D ** -0.5),
        'w2': nrm(ks[21], (DEPTH, N_EXPERTS, D_EXPERT, D), D_EXPERT ** -0.5),
    }


def reference(x, c, ctx, c_ctx, ada_w, ada_b, norm1_g, w_in, qn_g, kn_g, rpb, conv_w, w_f, w_na, w_cv, w_o,
              norm2_g, router_w, router_b, w1, w3, w2):
    bsz, L, d = x.shape
    cos, sin = axial_rope_tables(L, x.dtype)
    sc = jax.nn.silu(c)
    scc = jax.nn.silu(c_ctx)
    for l in range(DEPTH):
        last = l == DEPTH - 1
        mod = (sc @ ada_w[l] + ada_b[l])[:, None, :]
        mod_c = scc @ ada_w[l] + ada_b[l]
        sh1, sc1, g1, sh2, sc2, g2 = jnp.split(mod, 6, axis=-1)
        csh1, csc1, cg1, csh2, csc2, cg2 = jnp.split(mod_c, 6, axis=-1)

        hc = modulate(rmsnorm(ctx, norm1_g[l]), csh1, csc1)
        if last:
            k_c, v_c = kv_heads(hc @ w_in[l][:, COL_K:COL_CX], kn_g[l])
        else:
            Pc = hc @ w_in[l]
            q_c = q_heads(Pc[..., COL_Q:COL_K], qn_g[l])
            k_c, v_c = kv_heads(Pc[..., COL_K:COL_CX], kn_g[l])
            attn_c = context_attention(q_c, k_c, v_c)
            ctx_new = ctx + cg1 * merge_branches(Pc, attn_c, w_f[l], w_na[l], w_cv[l], conv_w[l], w_o[l])

        h = modulate(rmsnorm(x, norm1_g[l]), sh1, sc1)
        P = h @ w_in[l]
        q = apply_rope(q_heads(P[..., COL_Q:COL_K], qn_g[l]), cos, sin)
        k, v = kv_heads(P[..., COL_K:COL_CX], kn_g[l])
        k = apply_rope(k, cos, sin)
        attn = neighbourhood_attention(q, k, v, k_c, v_c, rpb[l])
        x = x + g1 * merge_branches(P, attn, w_f[l], w_na[l], w_cv[l], conv_w[l], w_o[l])

        h2 = modulate(rmsnorm(x, norm2_g[l]), sh2, sc2).reshape(bsz * L, d)
        if last:
            y = moe_ffn(h2, router_w, router_b, w1[l], w3[l], w2[l])
            x = x + g2 * y.reshape(bsz, L, d)
        else:
            h2c = modulate(rmsnorm(ctx_new, norm2_g[l]), csh2, csc2).reshape(bsz * CTX_LEN, d)
            y = moe_ffn(jnp.concatenate([h2, h2c], axis=0), router_w, router_b, w1[l], w3[l], w2[l])
            x = x + g2 * y[:bsz * L].reshape(bsz, L, d)
            ctx = ctx_new + cg2 * y[bsz * L:].reshape(bsz, CTX_LEN, d)
    return x
```

```cpp
#include <hip/hip_runtime.h>
#include <cstdio>
#include <cstdint>

namespace pg8 {
#define PG8_LAS __attribute__((address_space(3)))
typedef unsigned short bf16_t;
typedef short bf16x8 __attribute__((ext_vector_type(8)));
typedef float f32x4 __attribute__((ext_vector_type(4)));
typedef unsigned u32x4 __attribute__((ext_vector_type(4)));
typedef unsigned u32x2 __attribute__((ext_vector_type(2)));
constexpr int BM = 256, BK = 64, HALF = 128, HTB = HALF * BK * 2  , STAGE_BYTES = 8 * HTB, NXCD = 8, WGM = 8;

__host__ __device__ __forceinline__ int lds_byte(int r, int c) { const int st = (r >> 4) * 2 + (c >> 5), rr = r & 15, cc = c & 31, ob = rr * 64 + cc * 2; return st * 1024 + (ob ^ (((ob >> 9) & 1) << 5)); }
__host__ __device__ __forceinline__ void stage_rc(int b, int& R, int& C) { const int st = b / 1024, sb = b % 1024, swz = sb ^ (((sb >> 9) & 1) << 5); R = (st >> 1) * 16 + swz / 64; C = (st & 1) * 32 + (swz % 64) / 2; }
__host__ __device__ __forceinline__ int perm32(int rho) { const int n = rho >> 4, i = rho & 15; return 8 * (i >> 2) + 4 * n + (i & 3); }

struct Unit { int pm, pn, pb; };
struct Gemm { const bf16_t* A; const bf16_t* Bt; int M, N, K; };

struct Order {
    int nM, nN, nwg, G, c, exM0, exN, exPn0, nExtra, moeUnits; const PG8_LAS int* tile_e;
    __device__ void init(int nM_, int nN_, int G_, int c_) { nM = nM_; nN = nN_; nwg = nM * nN; G = G_; c = c_; exM0 = 0; exN = 1; exPn0 = 0; nExtra = 0; moeUnits = -1; tile_e = nullptr; }
    __device__ bool next(int i, Unit& u) const {
        const long L = (long)i * G + c;
        if (moeUnits >= 0) { if (L >= moeUnits) return false; const int t = (int)L >> 2; u.pm = t; u.pn = (int)L & 3; u.pb = tile_e[t] * 4 + u.pn; return true; }
        if (L >= nwg) { const int x = (int)(L - nwg); if (x >= nExtra) return false; u.pm = exM0 + x / exN; u.pn = exPn0 + x % exN; u.pb = u.pn; return true; }
        int wgid = (int)L; { const int q = nwg / NXCD, r = nwg % NXCD, xcd = wgid % NXCD, off = wgid / NXCD; wgid = (xcd < r ? xcd * (q + 1) : r * (q + 1) + (xcd - r) * q) + off; }
        const int nig = WGM * nN, gid = wgid / nig, fm = gid * WGM, gsz = (nM - fm) < WGM ? (nM - fm) : WGM;
        u.pm = fm + ((wgid % nig) % gsz); u.pn = (wgid % nig) / gsz; u.pb = u.pn; return true;
    }
    __device__ __forceinline__ void a_ready(const Unit&) const {}
    __device__ __forceinline__ void done(const Unit&) const {}
};

__device__ __forceinline__ unsigned cvt_pk_bf16(float lo, float hi) { unsigned r; asm volatile("v_cvt_pk_bf16_f32 %0, %1, %2" : "=v"(r) : "v"(lo), "v"(hi)); return r; }
__device__ __forceinline__ float bf_lo(unsigned w) { return __builtin_bit_cast(float, w << 16); }
__device__ __forceinline__ float bf_hi(unsigned w) { return __builtin_bit_cast(float, w & 0xffff0000u); }
__device__ __forceinline__ float sigmoidf_(float v) { return __builtin_amdgcn_rcpf(1.0f + __expf(-v)); }
__device__ __forceinline__ u32x4 pack8(const f32x4& v0, const f32x4& v1) { u32x4 w; w.x = cvt_pk_bf16(v0[0], v0[1]); w.y = cvt_pk_bf16(v0[2], v0[3]); w.z = cvt_pk_bf16(v1[0], v1[1]); w.w = cvt_pk_bf16(v1[2], v1[3]); return w; }

struct EpiPlain {
    static constexpr bool PERM = true, AFTER_DRAIN = false;
    bf16_t* O; int ldc;
    __device__ __forceinline__ void operator()(const f32x4 (&acc)[2][2][4][2], const Unit& u, int wr, int wc, int fr, int fq) const {
        const int row0 = u.pm * BM + wr * 64 + fr, col0 = u.pn * BM + wc * 32 + 8 * fq;
#pragma unroll
        for (int ai = 0; ai < 2; ++ai)
#pragma unroll
            for (int m = 0; m < 4; ++m) { bf16_t* rowp = O + (size_t)(row0 + ai * HALF + m * 16) * ldc + col0;
#pragma unroll
                for (int bj = 0; bj < 2; ++bj) *(u32x4*)(rowp + bj * HALF) = pack8(acc[ai][bj][m][0], acc[ai][bj][m][1]); }
    }
};

struct EpiIn {
    static constexpr bool PERM = true, AFTER_DRAIN = false;
    bf16_t* P; int ldc; const float* qg; const float* kg; const float2* rope; int latent_tiles;
    __device__ __forceinline__ void operator()(const f32x4 (&acc)[2][2][4][2], const Unit& u, int wr, int wc, int fr, int fq) const {
        const int pn = u.pn;
        const int row0 = u.pm * BM + wr * 64 + fr;
        if (pn >= 1 && pn <= 4) {
            const float* g = (pn <= 2) ? qg : kg;
            f32x4 gv[2][2];
#pragma unroll
            for (int bj = 0; bj < 2; ++bj)
#pragma unroll
                for (int n = 0; n < 2; ++n) gv[bj][n] = *(const f32x4*)(g + 32 * bj + 8 * fq + 4 * n);
            const bool lat = u.pm < latent_tiles;
#pragma unroll
            for (int ai = 0; ai < 2; ++ai)
#pragma unroll
                for (int m = 0; m < 4; ++m) {
                    float ss = 0.f;
#pragma unroll
                    for (int bj = 0; bj < 2; ++bj)
#pragma unroll
                        for (int n = 0; n < 2; ++n) { const f32x4 x = acc[ai][bj][m][n]; ss += (x[0] * x[0] + x[1] * x[1]) + (x[2] * x[2] + x[3] * x[3]); }
                    ss += __shfl_xor(ss, 16); ss += __shfl_xor(ss, 32);
                    const float rstd = __builtin_amdgcn_rsqf(ss * (1.0f / 64.0f) + 1e-6f);
                    f32x4 y[2][2];
#pragma unroll
                    for (int bj = 0; bj < 2; ++bj)
#pragma unroll
                        for (int n = 0; n < 2; ++n) y[bj][n] = acc[ai][bj][m][n] * rstd * gv[bj][n];
                    if (lat) {
                        const int pos = (fq < 2) ? ((4 * u.pm + 2 * ai + wr) & 63) : (16 * m + fr);
                        const float2* cs = rope + pos * 16 + 8 * (fq & 1);
#pragma unroll
                        for (int n = 0; n < 2; ++n)
#pragma unroll
                            for (int i = 0; i < 4; ++i) { const float2 c = cs[4 * n + i]; const float x1 = y[0][n][i], x2 = y[1][n][i]; y[0][n][i] = x1 * c.x - x2 * c.y; y[1][n][i] = x2 * c.x + x1 * c.y; }
                    }
                    bf16_t* rowp = P + (size_t)(row0 + ai * HALF + m * 16) * ldc + pn * BM + 64 * wc + 8 * fq;
#pragma unroll
                    for (int bj = 0; bj < 2; ++bj) *(u32x4*)(rowp + 32 * bj) = pack8(y[bj][0], y[bj][1]);
                }
        } else {
            const bool gate = pn >= 10;
            const int col0 = pn * BM + wc * 32 + 8 * fq;
#pragma unroll
            for (int ai = 0; ai < 2; ++ai)
#pragma unroll
                for (int m = 0; m < 4; ++m) { bf16_t* rowp = P + (size_t)(row0 + ai * HALF + m * 16) * ldc + col0;
#pragma unroll
                    for (int bj = 0; bj < 2; ++bj) { f32x4 v0 = acc[ai][bj][m][0], v1 = acc[ai][bj][m][1];
                        if (gate) {
#pragma unroll
                            for (int i = 0; i < 4; ++i) { v0[i] = sigmoidf_(v0[i]); v1[i] = sigmoidf_(v1[i]); } }
                        *(u32x4*)(rowp + bj * HALF) = pack8(v0, v1); } }
        }
    }
};

struct EpiMerge {
    static constexpr bool PERM = true, AFTER_DRAIN = false;
    bf16_t* MG; const bf16_t* P; int ldp; int goff; int accum;
    __device__ __forceinline__ void operator()(const f32x4 (&acc)[2][2][4][2], const Unit& u, int wr, int wc, int fr, int fq) const {
        const int row0 = u.pm * BM + wr * 64 + fr, col0 = u.pn * BM + wc * 32 + 8 * fq;
#pragma unroll
        for (int ai = 0; ai < 2; ++ai)
#pragma unroll
            for (int m = 0; m < 4; ++m) { const size_t row = (size_t)(row0 + ai * HALF + m * 16);
#pragma unroll
                for (int bj = 0; bj < 2; ++bj) {
                    const u32x4 gw = *(const u32x4*)(P + row * ldp + goff + col0 + bj * HALF);
                    f32x4 v0 = acc[ai][bj][m][0], v1 = acc[ai][bj][m][1];
                    v0[0] *= bf_lo(gw.x); v0[1] *= bf_hi(gw.x); v0[2] *= bf_lo(gw.y); v0[3] *= bf_hi(gw.y);
                    v1[0] *= bf_lo(gw.z); v1[1] *= bf_hi(gw.z); v1[2] *= bf_lo(gw.w); v1[3] *= bf_hi(gw.w);
                    bf16_t* op = MG + row * 1024 + col0 + bj * HALF;
                    if (accum) { const u32x4 o = *(const u32x4*)op;
                        v0[0] += bf_lo(o.x); v0[1] += bf_hi(o.x); v0[2] += bf_lo(o.y); v0[3] += bf_hi(o.y);
                        v1[0] += bf_lo(o.z); v1[1] += bf_hi(o.z); v1[2] += bf_lo(o.w); v1[3] += bf_hi(o.w); }
                    *(u32x4*)op = pack8(v0, v1); } }
    }
};

struct EpiOut {
    static constexpr bool PERM = true, AFTER_DRAIN = false;
    const float* baseL; float* outL; const float* baseC; float* outC; const float* gate;
    __device__ __forceinline__ void operator()(const f32x4 (&acc)[2][2][4][2], const Unit& u, int wr, int wc, int fr, int fq) const {
        const int col0 = u.pn * BM + wc * 32 + 8 * fq;
        const bool lat = u.pm < 64;
        const int j = lat ? (u.pm >> 4) : 4;
        const float* base = lat ? baseL : baseC; float* out = lat ? outL : outC;
        const int row0 = (lat ? u.pm : (u.pm - 64)) * BM + wr * 64 + fr;
        f32x4 gv[2][2];
#pragma unroll
        for (int bj = 0; bj < 2; ++bj)
#pragma unroll
            for (int n = 0; n < 2; ++n) gv[bj][n] = *(const f32x4*)(gate + (size_t)j * 6144 + col0 + bj * HALF + n * 4);
#pragma unroll
        for (int ai = 0; ai < 2; ++ai)
#pragma unroll
            for (int m = 0; m < 4; ++m) { const size_t off = (size_t)(row0 + ai * HALF + m * 16) * 1024 + col0;
#pragma unroll
                for (int bj = 0; bj < 2; ++bj)
#pragma unroll
                    for (int n = 0; n < 2; ++n) { const f32x4 b = *(const f32x4*)(base + off + bj * HALF + n * 4);
                        *(f32x4*)(out + off + bj * HALF + n * 4) = b + gv[bj][n] * acc[ai][bj][m][n]; } }
    }
};

struct EpiMoe1 {
    static constexpr bool PERM = true, AFTER_DRAIN = false;
    bf16_t* ACT;
    __device__ __forceinline__ void operator()(const f32x4 (&acc)[2][2][4][2], const Unit& u, int wr, int wc, int fr, int fq) const {
        const int row0 = u.pm * BM + wr * 64 + fr, col0 = u.pn * HALF + wc * 32 + 8 * fq;
#pragma unroll
        for (int ai = 0; ai < 2; ++ai)
#pragma unroll
            for (int m = 0; m < 4; ++m) { f32x4 v[2];
#pragma unroll
                for (int n = 0; n < 2; ++n)
#pragma unroll
                    for (int i = 0; i < 4; ++i) { const float a = acc[ai][0][m][n][i], b = acc[ai][1][m][n][i]; v[n][i] = a * sigmoidf_(a) * b; }
                *(u32x4*)(ACT + (size_t)(row0 + ai * HALF + m * 16) * 512 + col0) = pack8(v[0], v[1]); }
    }
};


template <class Epi, class Sched, bool ALIGN_EPI = false, bool SP2 = false>
__device__ __forceinline__ void gemm_phase(PG8_LAS unsigned char* lds, const Gemm g, const Sched& S, const Epi& E) {
    int tid_ = threadIdx.x; asm volatile("" : "+v"(tid_));
    const int tid = tid_, wid = __builtin_amdgcn_readfirstlane(tid >> 6), lane = tid & 63, wr = wid >> 2, wc = wid & 3, fr = lane & 15, fq = lane >> 4;
    const int K = g.K, nt = K / BK;
    unsigned voffA[2], voffB[2];
#pragma unroll
    for (int i = 0; i < 2; ++i) { int R, C; stage_rc(tid * 16 + i * 8192, R, C); const int Rb = Epi::PERM ? ((R & ~31) + perm32(R & 31)) : R;
        voffA[i] = (unsigned)(R * K + C) * 2u; voffB[i] = (unsigned)(Rb * K + C) * 2u; }
    const size_t kstep = (size_t)(BK * 2);
    const size_t hstep = (size_t)HALF * K * 2;
    const size_t tstep = 2 * hstep;
    const unsigned ldsw = (unsigned)wid * 1024u;
    const int aoff = lds_byte(wr * 64 + fr, fq * 8), boff = lds_byte(wc * 32 + fr, fq * 8);
#define PG8_SA(b, h) (((b) * 2 + (h)) * HTB)
#define PG8_SB(b, h) ((4 + (b) * 2 + (h)) * HTB)
#define PG8_STAGE(bufoff, gbase, voff) do { _Pragma("unroll") for (int _i = 0; _i < 2; ++_i) \
        __builtin_amdgcn_global_load_lds((const unsigned*)((const char*)(gbase) + (voff)[_i]), (PG8_LAS unsigned*)(lds + (bufoff) + ldsw + _i * 8192), 16, 0, 0); } while (0)
#define PG8_LDA(dst, b, h) do { _Pragma("unroll") for (int m = 0; m < 4; ++m) _Pragma("unroll") for (int k = 0; k < 2; ++k) dst[m][k] = *(const PG8_LAS bf16x8*)(lds + PG8_SA(b, h) + aoff + m * 2048 + k * 1024); } while (0)
#define PG8_LDB(dst, b, h) do { _Pragma("unroll") for (int n = 0; n < 2; ++n) _Pragma("unroll") for (int k = 0; k < 2; ++k) dst[n][k] = *(const PG8_LAS bf16x8*)(lds + PG8_SB(b, h) + boff + n * 2048 + k * 1024); } while (0)
#define PG8_MMA(ai, bj, At, Bt) do { __builtin_amdgcn_s_setprio(1); _Pragma("unroll") for (int m = 0; m < 4; ++m) _Pragma("unroll") for (int n = 0; n < 2; ++n) _Pragma("unroll") for (int k = 0; k < 2; ++k) \
        acc[ai][bj][m][n] = __builtin_amdgcn_mfma_f32_16x16x32_bf16(Bt[n][k], At[m][k], acc[ai][bj][m][n], 0, 0, 0); __builtin_amdgcn_s_setprio(0); } while (0)
#define PG8_WAIT_V(n) asm volatile("s_waitcnt vmcnt(" #n ")" ::: "memory")
#define PG8_WAIT_L(n) asm volatile("s_waitcnt lgkmcnt(" #n ")" ::: "memory")
#define PG8_BAR __builtin_amdgcn_s_barrier()
#define PG8_SCHED __builtin_amdgcn_sched_barrier(0)
    Unit cur, nxt; int ui = 0;
    if (!S.next(0, cur)) return;
    f32x4 acc[2][2][4][2];
#pragma unroll
    for (int a = 0; a < 2; ++a)
#pragma unroll
        for (int b = 0; b < 2; ++b)
#pragma unroll
            for (int m = 0; m < 4; ++m)
#pragma unroll
                for (int n = 0; n < 2; ++n) acc[a][b][m][n] = (f32x4){0.f, 0.f, 0.f, 0.f};
    bf16x8 At[4][2], B0[2][2], B1[2][2];
    const char* cA = (const char*)g.A + (size_t)cur.pm * tstep; const char* cB = (const char*)g.Bt + (size_t)cur.pb * tstep;
    S.a_ready(cur);
    if constexpr (SP2) {
        PG8_STAGE(PG8_SB(0, 0), cB, voffB); PG8_STAGE(PG8_SB(0, 1), cB + hstep, voffB); PG8_STAGE(PG8_SA(0, 0), cA, voffA); PG8_STAGE(PG8_SA(0, 1), cA + hstep, voffA);
        if (wr == 1) PG8_BAR;
        PG8_WAIT_V(2); PG8_BAR;
        PG8_STAGE(PG8_SB(1, 0), cB + kstep, voffB); PG8_STAGE(PG8_SA(1, 0), cA + kstep, voffA); PG8_STAGE(PG8_SB(1, 1), cB + hstep + kstep, voffB);
        PG8_WAIT_V(6); PG8_BAR;
    } else {
        PG8_STAGE(PG8_SB(0, 0), cB, voffB); PG8_STAGE(PG8_SA(0, 0), cA, voffA); PG8_STAGE(PG8_SB(0, 1), cB + hstep, voffB); PG8_STAGE(PG8_SA(0, 1), cA + hstep, voffA);
        if (wr == 1) PG8_BAR;
        PG8_WAIT_V(4); PG8_BAR;
        PG8_STAGE(PG8_SB(1, 0), cB + kstep, voffB); PG8_STAGE(PG8_SA(1, 0), cA + kstep, voffA); PG8_STAGE(PG8_SB(1, 1), cB + hstep + kstep, voffB);
        PG8_WAIT_V(6); PG8_BAR;
    }
    for (;;) {
        const bool has_next = S.next(ui + 1, nxt);
        const char* nA = has_next ? (const char*)g.A + (size_t)nxt.pm * tstep : cA; const char* nB = has_next ? (const char*)g.Bt + (size_t)nxt.pb * tstep : cB;
        for (int t = 0; t < nt; t += 2) {
            const bool last = (t == nt - 2);
            const char* a1 = cA + (size_t)(t + 1) * kstep;
            const char* a2 = last ? nA : cA + (size_t)(t + 2) * kstep; const char* b2 = last ? nB : cB + (size_t)(t + 2) * kstep;
            const char* a3 = a2 + kstep; const char* b3 = b2 + kstep;
            if (last && has_next) S.a_ready(nxt);
            if constexpr (SP2) {
            PG8_LDB(B0, 0, 0); PG8_LDB(B1, 0, 1); PG8_SCHED; PG8_LDA(At, 0, 0); PG8_STAGE(PG8_SA(1, 1), a1 + hstep, voffA);
            PG8_WAIT_V(8); PG8_WAIT_L(0); PG8_BAR; PG8_MMA(0, 0, At, B0); PG8_MMA(0, 1, At, B1); PG8_BAR; PG8_SCHED;
            PG8_LDA(At, 0, 1); PG8_STAGE(PG8_SB(0, 0), b2, voffB); PG8_STAGE(PG8_SB(0, 1), b2 + hstep, voffB); PG8_STAGE(PG8_SA(0, 0), a2, voffA);
            PG8_WAIT_V(8); PG8_WAIT_L(0); PG8_BAR; PG8_MMA(1, 0, At, B0); PG8_MMA(1, 1, At, B1); PG8_BAR; PG8_SCHED;
            PG8_LDB(B0, 1, 0); PG8_LDB(B1, 1, 1); PG8_SCHED; PG8_LDA(At, 1, 0); PG8_STAGE(PG8_SA(0, 1), a2 + hstep, voffA);
            PG8_WAIT_V(8); PG8_WAIT_L(0); PG8_BAR; PG8_MMA(0, 0, At, B0); PG8_MMA(0, 1, At, B1); PG8_BAR; PG8_SCHED;
            PG8_LDA(At, 1, 1); PG8_STAGE(PG8_SB(1, 0), b3, voffB); PG8_STAGE(PG8_SB(1, 1), b3 + hstep, voffB); PG8_STAGE(PG8_SA(1, 0), a3, voffA);
            PG8_WAIT_V(8); PG8_WAIT_L(0); PG8_BAR; PG8_MMA(1, 0, At, B0); PG8_MMA(1, 1, At, B1); PG8_BAR; PG8_SCHED;
            } else {
            PG8_LDB(B0, 0, 0); PG8_SCHED; PG8_LDA(At, 0, 0); PG8_STAGE(PG8_SA(1, 1), a1 + hstep, voffA);
            PG8_WAIT_L(8); PG8_BAR; PG8_WAIT_L(0); PG8_MMA(0, 0, At, B0); PG8_BAR; PG8_SCHED;
            PG8_LDB(B1, 0, 1); PG8_STAGE(PG8_SB(0, 0), b2, voffB);
            PG8_BAR; PG8_WAIT_L(0); PG8_MMA(0, 1, At, B1); PG8_BAR;
            PG8_LDA(At, 0, 1); PG8_STAGE(PG8_SA(0, 0), a2, voffA);
            PG8_BAR; PG8_WAIT_L(0); PG8_MMA(1, 0, At, B0); PG8_BAR; PG8_SCHED;
            PG8_STAGE(PG8_SB(0, 1), b2 + hstep, voffB);
            PG8_WAIT_V(6); PG8_BAR; PG8_MMA(1, 1, At, B1); PG8_BAR;
            PG8_LDB(B0, 1, 0); PG8_SCHED; PG8_LDA(At, 1, 0); PG8_STAGE(PG8_SA(0, 1), a2 + hstep, voffA);
            PG8_WAIT_L(8); PG8_BAR; PG8_WAIT_L(0); PG8_MMA(0, 0, At, B0); PG8_BAR; PG8_SCHED;
            PG8_LDB(B1, 1, 1); PG8_STAGE(PG8_SB(1, 0), b3, voffB);
            PG8_BAR; PG8_WAIT_L(0); PG8_MMA(0, 1, At, B1); PG8_BAR;
            PG8_LDA(At, 1, 1); PG8_STAGE(PG8_SA(1, 0), a3, voffA);
            PG8_BAR; PG8_WAIT_L(0); PG8_MMA(1, 0, At, B0); PG8_BAR; PG8_SCHED;
            PG8_STAGE(PG8_SB(1, 1), b3 + hstep, voffB);
            PG8_WAIT_V(6); PG8_BAR; PG8_MMA(1, 1, At, B1); PG8_BAR;
            }
        }
        if constexpr (ALIGN_EPI) { if (wr == 0) PG8_BAR; }
        if constexpr (!Epi::AFTER_DRAIN) { E(acc, cur, wr, wc, fr, fq); S.done(cur); }
        if (!has_next) break;
#pragma unroll
        for (int a = 0; a < 2; ++a)
#pragma unroll
            for (int b = 0; b < 2; ++b)
#pragma unroll
                for (int m = 0; m < 4; ++m)
#pragma unroll
                    for (int n = 0; n < 2; ++n) acc[a][b][m][n] = (f32x4){0.f, 0.f, 0.f, 0.f};
        cur = nxt; cA = nA; cB = nB; ++ui;
        if constexpr (ALIGN_EPI) { if (wr == 1) PG8_BAR; }
    }
    PG8_WAIT_V(0);
    if constexpr (!ALIGN_EPI) { if (wr == 0) PG8_BAR; }
    PG8_BAR;
    if constexpr (Epi::AFTER_DRAIN) { E.fused(acc, cur, wr, wc, fr, fq, lds, wid, lane); S.done(cur); }
#undef PG8_SA
#undef PG8_SB
#undef PG8_STAGE
#undef PG8_LDA
#undef PG8_LDB
#undef PG8_MMA
#undef PG8_WAIT_V
#undef PG8_WAIT_L
#undef PG8_BAR
#undef PG8_SCHED
}
}

#define GAS __attribute__((address_space(1)))
#define LAS __attribute__((address_space(3)))
typedef unsigned short bf16;
typedef unsigned v4u __attribute__((ext_vector_type(4)));
typedef unsigned v2u __attribute__((ext_vector_type(2)));
typedef float f32x4 __attribute__((ext_vector_type(4)));
typedef float f32x2 __attribute__((ext_vector_type(2)));
#define LDS_WAIT() asm volatile("s_waitcnt lgkmcnt(0)" ::: "memory")
#define VM_WAIT() asm volatile("s_waitcnt vmcnt(0)" ::: "memory")

constexpr int D = 1024, NB = 4, SEQ = 4096, CTXL = 256, INW = 5632, DEPTH = 2;
constexpr int ML = NB * SEQ, MC = NB * CTXL, MA = ML + MC;
constexpr int COL_F = 0, COL_Q = 256, COL_K = 768, COL_V = 1280, COL_CX = 1792, COL_CB = 2048, COL_CC = 2304, COL_G = 2560;
constexpr int NE = 16, DE = 512;
constexpr int XG_ROWS = 39168;
constexpr int NWAVES = 8, NT = 512;
constexpr int LDS_BYTES = 163840;
constexpr int LDS_TILE_E = 131072, LDS_MISC = 163840 - 256, LDS_ATAB = 163840 - 512;

constexpr size_t MiB = 1u << 20;
constexpr size_t WS_CTL = 0, CTL_ZERO_BYTES = 65536;
constexpr size_t WS_MOD = 1 * MiB;
constexpr size_t WS_ROPE = WS_MOD + 256 * 1024, WS_TW = WS_MOD + 320 * 1024;
constexpr size_t WS_WIN = 2 * MiB, WS_WF = 13 * MiB, WS_WNA = 14 * MiB, WS_WCV = 15 * MiB, WS_WO = 16 * MiB, WS_W13 = 18 * MiB, WS_W2 = 50 * MiB;
constexpr size_t WS_H = 66 * MiB;
constexpr size_t WS_ATT = 100 * MiB, WS_FY = 117 * MiB, WS_YCV = 134 * MiB, WS_CTXN = 143 * MiB, WS_ROUTE = 151 * MiB;
constexpr size_t WS_P = 152 * MiB;
constexpr size_t WS_XG = 152 * MiB, WS_ACT = 229 * MiB, WS_Y = 268 * MiB;
constexpr size_t WS_END = WS_Y + (size_t)XG_ROWS * 1024 * 2;
static_assert(WS_P + (size_t)MA * INW * 2 <= 340 * MiB && WS_XG + (size_t)XG_ROWS * 2048 <= WS_ACT && WS_ACT + (size_t)XG_ROWS * 1024 <= WS_Y, "ws map");
constexpr int CW_CNT = 64;
constexpr int CW_BAR = 4096;

__device__ __forceinline__ unsigned f2bf(float f) { unsigned u = __builtin_bit_cast(unsigned, f); return (u + 0x7fffu + ((u >> 16) & 1u)) >> 16; }
__device__ __forceinline__ unsigned pk2(float lo, float hi) { return f2bf(lo) | (f2bf(hi) << 16); }
__device__ __forceinline__ float bf2f(unsigned short h) { return __builtin_bit_cast(float, (unsigned)h << 16); }
__device__ __forceinline__ float wave_sum(float v) {
#pragma unroll
    for (int o = 1; o < 64; o <<= 1) v += __shfl_xor(v, o);
    return v;
}
__device__ __forceinline__ float wave_max(float v) {
#pragma unroll
    for (int o = 1; o < 64; o <<= 1) v = fmaxf(v, __shfl_xor(v, o));
    return v;
}

struct Args {
    const float *x, *c, *ctx, *c_ctx, *ada_w, *ada_b, *norm1_g, *w_in, *qn_g, *kn_g, *rpb, *conv_w, *w_f, *w_na, *w_cv, *w_o, *norm2_g, *router_w, *router_b, *w1, *w3, *w2;
    float* out; unsigned char* ws; int ph_lo, ph_hi;
};

struct Frame {
    LAS unsigned char* lds;
    int tid, lane, wave, G, bid, gw, NGW;
};

__device__ __forceinline__ unsigned long long ldp(LAS unsigned char* lds, int i) {
    const volatile LAS unsigned* t = (const volatile LAS unsigned*)(lds + LDS_ATAB);
    const unsigned lo = __builtin_amdgcn_readfirstlane(t[2 * i]), hi = __builtin_amdgcn_readfirstlane(t[2 * i + 1]);
    return ((unsigned long long)hi << 32) | lo;
}
__device__ __forceinline__ Args load_args(LAS unsigned char* lds) {
    Args a;
    a.x = (const float*)ldp(lds, 0); a.c = (const float*)ldp(lds, 1); a.ctx = (const float*)ldp(lds, 2); a.c_ctx = (const float*)ldp(lds, 3);
    a.ada_w = (const float*)ldp(lds, 4); a.ada_b = (const float*)ldp(lds, 5); a.norm1_g = (const float*)ldp(lds, 6); a.w_in = (const float*)ldp(lds, 7);
    a.qn_g = (const float*)ldp(lds, 8); a.kn_g = (const float*)ldp(lds, 9); a.rpb = (const float*)ldp(lds, 10); a.conv_w = (const float*)ldp(lds, 11);
    a.w_f = (const float*)ldp(lds, 12); a.w_na = (const float*)ldp(lds, 13); a.w_cv = (const float*)ldp(lds, 14); a.w_o = (const float*)ldp(lds, 15);
    a.norm2_g = (const float*)ldp(lds, 16); a.router_w = (const float*)ldp(lds, 17); a.router_b = (const float*)ldp(lds, 18);
    a.w1 = (const float*)ldp(lds, 19); a.w3 = (const float*)ldp(lds, 20); a.w2 = (const float*)ldp(lds, 21);
    a.out = (float*)ldp(lds, 22); a.ws = (unsigned char*)ldp(lds, 23); a.ph_lo = 0; a.ph_hi = 0;
    return a;
}

__device__ __forceinline__ void tr_tile(const float* Wp, int ldw, bf16* WTp, int ldo, LAS float* scr, int lane) {
#pragma unroll 8
    for (int i = 0; i < 32; ++i) { const int kk = 2 * i + (lane >> 5); scr[kk * 33 + (lane & 31)] = Wp[(size_t)kk * ldw + (lane & 31)]; }
    LDS_WAIT(); asm volatile("" ::: "memory");
    const int c = lane & 7;
#pragma unroll
    for (int j = 0; j < 4; ++j) { const int n = (lane >> 3) + 8 * j; const LAS float* s = scr + (8 * c) * 33 + n;
        v4u o; o.x = pk2(s[0 * 33], s[1 * 33]); o.y = pk2(s[2 * 33], s[3 * 33]); o.z = pk2(s[4 * 33], s[5 * 33]); o.w = pk2(s[6 * 33], s[7 * 33]);
        *(v4u*)(WTp + (size_t)n * ldo + 8 * c) = o; }
    LDS_WAIT(); asm volatile("" ::: "memory");
}

__device__ __forceinline__ void convert_weights(const Frame& F, int l) {
    const Args a = load_args(F.lds);
    LAS float* scr = (LAS float*)(F.lds + F.wave * 8448);
    unsigned char* ws = a.ws;
    bf16* WIN = (bf16*)(ws + WS_WIN); bf16* WNA = (bf16*)(ws + WS_WNA); bf16* WCV = (bf16*)(ws + WS_WCV); bf16* WO = (bf16*)(ws + WS_WO);
    bf16* W13 = (bf16*)(ws + WS_W13); bf16* W2 = (bf16*)(ws + WS_W2); bf16* WF = (bf16*)(ws + WS_WF);
    constexpr int I_IN = 16 * 176, I_NA = 8 * 32, I_CV = 4 * 32, I_O = 16 * 32, I_E1 = 16 * 256, I_E2 = 16 * 256;
    constexpr int NITEMS = I_IN + I_NA + I_CV + I_O + 2 * I_E1 + I_E2;
    for (int it = F.gw; it < NITEMS; it += F.NGW) {
        int r = it;
        if (r < I_IN) { const int kb = r / 176, nb = r % 176, n0 = 32 * nb, k0 = 64 * kb;
            int drow = n0;
            if (n0 >= COL_Q && n0 < COL_V) { const int pn = n0 >> 8, w = n0 & 255, wc = w >> 6, dd = w & 63; drow = pn * 256 + 128 * (dd >> 5) + 32 * wc + (dd & 31); }
            tr_tile(a.w_in + (size_t)l * D * INW + (size_t)k0 * INW + n0, INW, WIN + (size_t)drow * D + k0, D, scr, F.lane); continue; }
        r -= I_IN;
        if (r < I_NA) { const int kb = r / 32, nb = r % 32; tr_tile(a.w_na + (size_t)l * 512 * D + (size_t)(64 * kb) * D + 32 * nb, D, WNA + (size_t)(32 * nb) * 512 + 64 * kb, 512, scr, F.lane); continue; }
        r -= I_NA;
        if (r < I_CV) { const int kb = r / 32, nb = r % 32; tr_tile(a.w_cv + (size_t)l * 256 * D + (size_t)(64 * kb) * D + 32 * nb, D, WCV + (size_t)(32 * nb) * 256 + 64 * kb, 256, scr, F.lane); continue; }
        r -= I_CV;
        if (r < I_O) { const int kb = r / 32, nb = r % 32; tr_tile(a.w_o + (size_t)l * D * D + (size_t)(64 * kb) * D + 32 * nb, D, WO + (size_t)(32 * nb) * D + 64 * kb, D, scr, F.lane); continue; }
        r -= I_O;
        if (r < 2 * I_E1) { const int which = r / I_E1; r -= which * I_E1; const int e = r >> 8, q = r & 255, kb = q >> 4, nb = q & 15, n0 = 32 * nb;
            const float* W = (which ? a.w3 : a.w1) + ((size_t)(l * NE + e) * D + 64 * kb) * DE + n0;
            const int drow = (n0 >> 7) * 256 + which * 128 + (n0 & 127);
            tr_tile(W, DE, W13 + (size_t)e * D * D + (size_t)drow * D + 64 * kb, D, scr, F.lane); continue; }
        r -= 2 * I_E1;
        { const int e = r >> 8, q = r & 255, kb = q >> 5, nb = q & 31;
          tr_tile(a.w2 + ((size_t)(l * NE + e) * DE + 64 * kb) * D + 32 * nb, D, W2 + (size_t)e * D * DE + (size_t)(32 * nb) * DE + 64 * kb, DE, scr, F.lane); }
    }
    const float* wf = a.w_f + (size_t)l * 256 * D;
    for (int o = F.bid * NT + F.tid; o < 512 * 1024; o += F.G * NT) {
        const int n = o & 1023, kk = o >> 10, cc = kk & 63, g = (kk >> 6) & 3; const bool sn = kk >= 256;
        float s = 0.f;
        for (int m = 0; m < 64; ++m) { const int idx = (m * cc) & 63; float sv, cv; __sincosf((float)idx * 0.09817477042468103f, &sv, &cv);
            s += (sn ? sv : cv) * wf[(size_t)(g * 64 + m) * D + n]; }
        WF[(size_t)n * 512 + kk] = (bf16)f2bf(s * 0.125f);
    }
}

__device__ __forceinline__ void phase_prologue(const Frame& F) {
    const Args a = load_args(F.lds);
    float2* rope = (float2*)(a.ws + WS_ROPE); float2* tw = (float2*)(a.ws + WS_TW); float* mod = (float*)(a.ws + WS_MOD);
    const int gt = F.bid * NT + F.tid, GT = F.G * NT;
    for (int i = gt; i < 1024; i += GT) { const int pos = i >> 4, f = i & 15; const float inv = powf(10000.0f, -(float)f / 16.0f); const float ang = (float)pos * inv; rope[i] = make_float2(cosf(ang), sinf(ang)); }
    for (int i = gt; i < 4096; i += GT) { const float ang = (float)i * (6.283185307179586f / 4096.0f); tw[i] = make_float2(cosf(ang), sinf(ang)); }
    if (F.bid < 192) {
        LAS float* s = (LAS float*)(F.lds + 70000);
        LAS float* red = (LAS float*)(F.lds + 70000 + 20480);
        for (int i = F.tid; i < 5 * 1024; i += NT) { const int j = i >> 10, k = i & 1023; const float v = (j < 4) ? a.c[j * 1024 + k] : a.c_ctx[k]; s[i] = v / (1.0f + __expf(-v)); }
        __syncthreads();
        for (int it = F.bid; it < 192; it += F.G) {
            const int l = it / 96, n0 = (it % 96) * 64;
            float acc[5] = {0.f, 0.f, 0.f, 0.f, 0.f};
            const float* w = a.ada_w + ((size_t)l * 1024 + F.wave * 128) * 6144 + n0 + F.lane;
            for (int k = 0; k < 128; ++k) { const float wv = w[(size_t)k * 6144];
#pragma unroll
                for (int j = 0; j < 5; ++j) acc[j] += s[j * 1024 + F.wave * 128 + k] * wv; }
#pragma unroll
            for (int j = 0; j < 5; ++j) red[(F.wave * 5 + j) * 64 + F.lane] = acc[j];
            __syncthreads();
            if (F.tid < 320) { const int j = F.tid >> 6, ln = F.tid & 63; float t = a.ada_b[l * 6144 + n0 + ln];
                for (int w8 = 0; w8 < 8; ++w8) t += red[(w8 * 5 + j) * 64 + ln];
                mod[(size_t)(l * 5 + j) * 6144 + n0 + ln] = t; }
            __syncthreads();
        }
    }
    convert_weights(F, 0);
}

__device__ __forceinline__ void norm_mod_store(f32x4 (&v)[4], const float* g, const float* sh, const float* sc, bf16* orow, int lane) {
    float s = 0.f;
#pragma unroll
    for (int j = 0; j < 4; ++j) s += (v[j].x * v[j].x + v[j].y * v[j].y) + (v[j].z * v[j].z + v[j].w * v[j].w);
    const float rstd = 1.0f / sqrtf(wave_sum(s) * (1.0f / 1024.0f) + 1e-6f);
#pragma unroll
    for (int j = 0; j < 4; ++j) { const int k = 4 * lane + 256 * j;
        const f32x4 gg = *(const f32x4*)(g + k), ss = *(const f32x4*)(sh + k), cc = *(const f32x4*)(sc + k);
        const f32x4 y = v[j] * rstd * gg * (cc + 1.0f) + ss;
        v[j] = y;
        *(v2u*)(orow + k) = (v2u){pk2(y.x, y.y), pk2(y.z, y.w)}; }
}

__device__ __forceinline__ void phase_norm_a0(const Frame& F) {
    const Args a = load_args(F.lds);
    const float* mod = (const float*)(a.ws + WS_MOD); bf16* H = (bf16*)(a.ws + WS_H);
    for (int r = F.gw; r < MA; r += F.NGW) {
        const float* src = (r < ML) ? a.x + (size_t)r * D : a.ctx + (size_t)(r - ML) * D;
        const int j = (r < ML) ? (r >> 12) : 4;
        f32x4 v[4];
#pragma unroll
        for (int q = 0; q < 4; ++q) v[q] = *(const f32x4*)(src + 4 * F.lane + 256 * q);
        const float* m = mod + (size_t)j * 6144;
        norm_mod_store(v, a.norm1_g, m, m + 1024, H + (size_t)r * D, F.lane);
    }
}

__device__ __forceinline__ void phase_conv(const Frame& F, int l) {
    const Args a = load_args(F.lds);
    const bf16* P = (const bf16*)(a.ws + WS_P); bf16* Y = (bf16*)(a.ws + WS_YCV);
    const float* cw = a.conv_w + l * 3 * 256;
    const int rows = (l == 0) ? MA : ML;
    for (int o = F.bid * NT + F.tid; o < rows * 32; o += F.G * NT) {
        const int r = o >> 5, c0 = (o & 31) * 8;
        int tpos, len; if (r < ML) { tpos = r & 4095; len = 4096; } else { tpos = (r - ML) & 255; len = 256; }
        const bf16* pr = P + (size_t)r * INW;
        float u0[8], u1[8], u2[8], bg[8];
        { const v4u x = *(const v4u*)(pr + COL_CX + c0), c = *(const v4u*)(pr + COL_CC + c0), b = *(const v4u*)(pr + COL_CB + c0);
          const unsigned xs[4] = {x.x, x.y, x.z, x.w}, cs[4] = {c.x, c.y, c.z, c.w}, bs[4] = {b.x, b.y, b.z, b.w};
#pragma unroll
          for (int q = 0; q < 4; ++q) { u1[2 * q] = pg8::bf_lo(xs[q]) * pg8::bf_lo(cs[q]); u1[2 * q + 1] = pg8::bf_hi(xs[q]) * pg8::bf_hi(cs[q]); bg[2 * q] = pg8::bf_lo(bs[q]); bg[2 * q + 1] = pg8::bf_hi(bs[q]); } }
        if (tpos > 0) { const v4u x = *(const v4u*)(pr - INW + COL_CX + c0), c = *(const v4u*)(pr - INW + COL_CC + c0);
          const unsigned xs[4] = {x.x, x.y, x.z, x.w}, cs[4] = {c.x, c.y, c.z, c.w};
#pragma unroll
          for (int q = 0; q < 4; ++q) { u0[2 * q] = pg8::bf_lo(xs[q]) * pg8::bf_lo(cs[q]); u0[2 * q + 1] = pg8::bf_hi(xs[q]) * pg8::bf_hi(cs[q]); } }
        else {
#pragma unroll
          for (int q = 0; q < 8; ++q) u0[q] = 0.f; }
        if (tpos < len - 1) { const v4u x = *(const v4u*)(pr + INW + COL_CX + c0), c = *(const v4u*)(pr + INW + COL_CC + c0);
          const unsigned xs[4] = {x.x, x.y, x.z, x.w}, cs[4] = {c.x, c.y, c.z, c.w};
#pragma unroll
          for (int q = 0; q < 4; ++q) { u2[2 * q] = pg8::bf_lo(xs[q]) * pg8::bf_lo(cs[q]); u2[2 * q + 1] = pg8::bf_hi(xs[q]) * pg8::bf_hi(cs[q]); } }
        else {
#pragma unroll
          for (int q = 0; q < 8; ++q) u2[q] = 0.f; }
        float y[8];
#pragma unroll
        for (int q = 0; q < 8; ++q) y[q] = bg[q] * (cw[c0 + q] * u0[q] + cw[256 + c0 + q] * u1[q] + cw[512 + c0 + q] * u2[q]);
        *(v4u*)(Y + (size_t)r * 256 + c0) = (v4u){pk2(y[0], y[1]), pk2(y[2], y[3]), pk2(y[4], y[5]), pk2(y[6], y[7])};
    }
}

__device__ __forceinline__ void phase_attn_simple(const Frame& F, int l) {
    const Args a = load_args(F.lds);
    const bf16* P = (const bf16*)(a.ws + WS_P); bf16* ATT = (bf16*)(a.ws + WS_ATT);
    LAS bf16* Ks = (LAS bf16*)(F.lds);
    LAS bf16* Vs = (LAS bf16*)(F.lds + 67584);
    LAS float* pb = (LAS float*)(F.lds + 133120) + F.wave * 256;
    LAS float* st = (LAS float*)(F.lds + 141312) + F.wave * 8 * 66;
    const float* rpb = a.rpb + (size_t)l * 8 * 15 * 31;
    const int nItems = 2048 + (l == 0 ? 128 : 0);
    for (int it = F.bid; it < nItems; it += F.G) {
        int b, r = 0, h, qrow0, rs = 0; bool local;
        if (it < 2048) { b = it >> 9; r = (it >> 3) & 63; h = it & 7; qrow0 = b * 4096 + r * 64; local = true; rs = r - 4; rs = rs < 0 ? 0 : (rs > 56 ? 56 : rs); }
        else { const int j = it - 2048; b = j >> 5; h = (j >> 2) & 7; qrow0 = ML + b * 256 + (j & 3) * 64; local = false; }
        for (int i = F.lane; i < 8 * 66; i += 64) { const int q = i / 66, e = i % 66; st[i] = (e == 64) ? -1e30f : 0.f; }
        for (int stage = local ? 0 : 1; stage < 2; ++stage) {
            __syncthreads();
            const int nk = stage == 0 ? 512 : 256;
            const size_t krow0 = stage == 0 ? (size_t)b * 4096 + rs * 64 : (size_t)ML + b * 256;
            for (int i = F.tid; i < nk * 8; i += NT) { const int key = i >> 3, ch = i & 7;
                const bf16* src = P + (krow0 + key) * INW + h * 64 + ch * 8;
                const v4u kv = *(const v4u*)(src + COL_K), vv = *(const v4u*)(src + COL_V);
                LAS unsigned* kd = (LAS unsigned*)(Ks + key * 66 + ch * 8); kd[0] = kv.x; kd[1] = kv.y; kd[2] = kv.z; kd[3] = kv.w;
                *(LAS v4u*)(Vs + key * 64 + ch * 8) = vv; }
            __syncthreads();
            for (int q = 0; q < 8; ++q) {
                const int qi = F.wave * 8 + q;
                float qv[64];
                { const bf16* qp = P + (size_t)(qrow0 + qi) * INW + COL_Q + h * 64;
#pragma unroll
                  for (int c = 0; c < 8; ++c) { const v4u w = *(const v4u*)(qp + c * 8); const unsigned ws4[4] = {w.x, w.y, w.z, w.w};
#pragma unroll
                      for (int e = 0; e < 4; ++e) { qv[c * 8 + 2 * e] = pg8::bf_lo(ws4[e]); qv[c * 8 + 2 * e + 1] = pg8::bf_hi(ws4[e]); } } }
                int cs = qi - 8; cs = cs < 0 ? 0 : (cs > 48 ? 48 : cs);
                const int nch = stage == 0 ? 2 : 4;
                float sc[4]; float mx = -1e30f;
#pragma unroll
                for (int c = 0; c < 4; ++c) { sc[c] = -1e30f;
                    if (c < nch) {
                        int kidx; float bias = 0.f;
                        if (stage == 0) { const int i = c * 4 + (F.lane >> 4), kc = cs + (F.lane & 15); kidx = i * 64 + kc; bias = rpb[(h * 15 + (rs + i - r + 7)) * 31 + (kc - qi + 15)]; }
                        else kidx = c * 64 + F.lane;
                        const LAS unsigned* kp = (const LAS unsigned*)(Ks + kidx * 66);
                        float d = 0.f;
#pragma unroll
                        for (int e = 0; e < 32; ++e) { const unsigned w = kp[e]; d += qv[2 * e] * pg8::bf_lo(w) + qv[2 * e + 1] * pg8::bf_hi(w); }
                        sc[c] = d * 0.125f + bias; mx = fmaxf(mx, sc[c]); } }
                mx = wave_max(mx);
                const float m_old = st[q * 66 + 64], l_old = st[q * 66 + 65], o_old = st[q * 66 + F.lane];
                const float m_new = fmaxf(m_old, mx), alpha = __expf(m_old - m_new);
                float psum = 0.f;
#pragma unroll
                for (int c = 0; c < 4; ++c) if (c < nch) { const float p = __expf(sc[c] - m_new); psum += p; pb[c * 64 + F.lane] = p; }
                psum = wave_sum(psum);
                LDS_WAIT(); asm volatile("" ::: "memory");
                float o = o_old * alpha;
                const int nkq = nch * 64;
                for (int j = 0; j < nkq; ++j) {
                    int kidx; if (stage == 0) { const int c = j >> 6, ln = j & 63; kidx = (c * 4 + (ln >> 4)) * 64 + cs + (ln & 15); } else kidx = j;
                    o += pb[j] * bf2f(Vs[kidx * 64 + F.lane]); }
                st[q * 66 + F.lane] = o;
                if (F.lane == 0) { st[q * 66 + 64] = m_new; st[q * 66 + 65] = l_old * alpha + psum; }
                LDS_WAIT(); asm volatile("" ::: "memory");
            }
        }
        for (int q = 0; q < 8; ++q) { const int qi = F.wave * 8 + q; const float o = st[q * 66 + F.lane] / st[q * 66 + 65];
            ATT[(size_t)(qrow0 + qi) * 512 + h * 64 + F.lane] = (bf16)f2bf(o); }
        LDS_WAIT(); asm volatile("" ::: "memory");
    }
    __syncthreads();
}

__device__ __forceinline__ void phase_fourier_simple(const Frame& F, int l) {
    const Args a = load_args(F.lds);
    const bf16* P = (const bf16*)(a.ws + WS_P); bf16* FY = (bf16*)(a.ws + WS_FY);
    const float2* tw = (const float2*)(a.ws + WS_TW);
    LAS float* X = (LAS float*)(F.lds);
    LAS f32x2* Z = (LAS f32x2*)(F.lds + 32768);
    LAS float* c64 = (LAS float*)(F.lds + 32768 + 66048); LAS float* s64 = c64 + 64;
    LAS float* c256 = s64 + 64; LAS float* s256 = c256 + 256;
    __syncthreads();
    if (F.tid < 64) { float sv, cv; sincosf((float)F.tid * 0.09817477042468103f, &sv, &cv); c64[F.tid] = cv; s64[F.tid] = sv; }
    if (F.tid < 256) { float sv, cv; sincosf((float)F.tid * 0.02454369260617026f, &sv, &cv); c256[F.tid] = cv; s256[F.tid] = sv; }
    __syncthreads();
    const int g = F.tid >> 7, lo = F.tid & 127;
    for (int it = F.bid; it < 512; it += F.G) {
        const int b = it >> 7, c0 = (it & 127) * 2;
        __syncthreads();
        for (int t = F.tid; t < 4096; t += NT) { const unsigned w = *(const unsigned*)(P + (size_t)(b * 4096 + t) * INW + COL_F + c0); X[2 * t] = pg8::bf_lo(w); X[2 * t + 1] = pg8::bf_hi(w); }
        __syncthreads();
        {
            float ar[16], ai[16];
#pragma unroll
            for (int k = 0; k < 16; ++k) { ar[k] = 0.f; ai[k] = 0.f; }
            for (int t1 = 0; t1 < 64; ++t1) { const float x = X[t1 * 128 + lo];
#pragma unroll
                for (int k = 0; k < 16; ++k) { const int idx = ((g * 16 + k) * t1) & 63; ar[k] += x * c64[idx]; ai[k] -= x * s64[idx]; } }
            const int t2 = lo >> 1;
#pragma unroll
            for (int k = 0; k < 16; ++k) { const int k1 = g * 16 + k; const float2 w = tw[t2 * k1];
                Z[k1 * 129 + lo] = (f32x2){ar[k] * w.x + ai[k] * w.y, ai[k] * w.x - ar[k] * w.y}; }
        }
        __syncthreads();
        {
            float yr[16], yi[16];
#pragma unroll
            for (int k = 0; k < 16; ++k) { yr[k] = 0.f; yi[k] = 0.f; }
            const int k1 = lo >> 1, c = lo & 1;
            for (int t2 = 0; t2 < 64; ++t2) { const f32x2 z = Z[k1 * 129 + t2 * 2 + c];
#pragma unroll
                for (int k = 0; k < 16; ++k) { const int idx = ((g * 16 + k) * t2) & 63; const float cv = c64[idx], sv = s64[idx]; yr[k] += z.x * cv + z.y * sv; yi[k] += z.y * cv - z.x * sv; } }
#pragma unroll
            for (int k = 0; k < 16; ++k) { const int k2 = g * 16 + k; bf16* o = FY + (size_t)(b * 4096 + k1 + 64 * k2) * 512 + c0 + c;
                o[0] = (bf16)f2bf(yr[k] * (1.0f / 64.0f)); o[256] = (bf16)f2bf(yi[k] * (1.0f / 64.0f)); }
        }
    }
    if (l == 0) {
        for (int it = F.bid; it < 512; it += F.G) {
            const int b = it >> 7, c0 = (it & 127) * 2;
            __syncthreads();
            if (F.tid < 256) { const unsigned w = *(const unsigned*)(P + (size_t)(ML + b * 256 + F.tid) * INW + COL_F + c0); X[2 * F.tid] = pg8::bf_lo(w); X[2 * F.tid + 1] = pg8::bf_hi(w); }
            __syncthreads();
            const int k = F.tid >> 1, c = F.tid & 1; float yr = 0.f, yi = 0.f;
            for (int t = 0; t < 256; ++t) { const float x = X[2 * t + c]; const int idx = (k * t) & 255; yr += x * c256[idx]; yi -= x * s256[idx]; }
            bf16* o = FY + (size_t)(ML + b * 256 + k) * 512 + c0 + c;
            o[0] = (bf16)f2bf(yr * (1.0f / 16.0f)); o[256] = (bf16)f2bf(yi * (1.0f / 16.0f));
        }
    }
    __syncthreads();
}

__device__ __forceinline__ void phase_route(const Frame& F, int l) {
    const Args a = load_args(F.lds);
    const float* mod = (const float*)(a.ws + WS_MOD) + (size_t)l * 5 * 6144; bf16* H = (bf16*)(a.ws + WS_H);
    const float* ctxn = (const float*)(a.ws + WS_CTXN);
    int* route = (int*)(a.ws + WS_ROUTE);
    unsigned* cnt = (unsigned*)(a.ws + WS_CTL) + CW_CNT + l * 16;
    const int rows = (l == 0) ? MA : ML;
    for (int r = F.gw; r < rows; r += F.NGW) {
        const float* src = (r < ML) ? a.out + (size_t)r * D : ctxn + (size_t)(r - ML) * D;
        const int j = (r < ML) ? (r >> 12) : 4;
        f32x4 v[4];
#pragma unroll
        for (int q = 0; q < 4; ++q) v[q] = *(const f32x4*)(src + 4 * F.lane + 256 * q);
        const float* m = mod + (size_t)j * 6144;
        norm_mod_store(v, a.norm2_g + l * 1024, m + 3072, m + 4096, H + (size_t)r * D, F.lane);
        float lg[16];
#pragma unroll
        for (int e = 0; e < 16; ++e) lg[e] = 0.f;
#pragma unroll
        for (int q = 0; q < 4; ++q)
#pragma unroll
            for (int i = 0; i < 4; ++i) { const float hv = v[q][i]; const f32x4* rw = (const f32x4*)(a.router_w + (size_t)(4 * F.lane + 256 * q + i) * 16);
#pragma unroll
                for (int e4 = 0; e4 < 4; ++e4) { const f32x4 w = rw[e4]; lg[4 * e4] += hv * w.x; lg[4 * e4 + 1] += hv * w.y; lg[4 * e4 + 2] += hv * w.z; lg[4 * e4 + 3] += hv * w.w; } }
#pragma unroll
        for (int e = 0; e < 16; ++e) lg[e] = wave_sum(lg[e]);
        float s[16], sb[16];
#pragma unroll
        for (int e = 0; e < 16; ++e) { s[e] = 1.0f / (1.0f + expf(-lg[e])); sb[e] = s[e] + a.router_b[e]; }
        int bg = 0; float bgs = -1e30f;
#pragma unroll
        for (int g = 0; g < 4; ++g) { float m1 = -1e30f, m2 = -1e30f;
#pragma unroll
            for (int k = 0; k < 4; ++k) { const float x = sb[4 * g + k]; if (x > m1) { m2 = m1; m1 = x; } else if (x > m2) m2 = x; }
            const float gs = m1 + m2; if (gs > bgs) { bgs = gs; bg = g; } }
        float gsb[4], gs_[4];
#pragma unroll
        for (int k = 0; k < 4; ++k) { gsb[k] = bg == 0 ? sb[k] : (bg == 1 ? sb[4 + k] : (bg == 2 ? sb[8 + k] : sb[12 + k])); gs_[k] = bg == 0 ? s[k] : (bg == 1 ? s[4 + k] : (bg == 2 ? s[8 + k] : s[12 + k])); }
        int i1 = 0; float b1 = gsb[0], s1 = gs_[0];
#pragma unroll
        for (int k = 1; k < 4; ++k) if (gsb[k] > b1) { b1 = gsb[k]; i1 = k; s1 = gs_[k]; }
        int i2 = -1; float b2 = -1e30f, s2 = 0.f;
#pragma unroll
        for (int k = 0; k < 4; ++k) if (k != i1 && gsb[k] > b2) { b2 = gsb[k]; i2 = k; s2 = gs_[k]; }
        if (F.lane == 0) {
            const int e0 = bg * 4 + i1, e1 = bg * 4 + i2;
            const unsigned p0 = __hip_atomic_fetch_add(cnt + e0, 1u, __ATOMIC_RELAXED, __HIP_MEMORY_SCOPE_AGENT);
            const unsigned p1 = __hip_atomic_fetch_add(cnt + e1, 1u, __ATOMIC_RELAXED, __HIP_MEMORY_SCOPE_AGENT);
            const float inv = 1.0f / (s1 + s2);
            int* rr = route + (size_t)r * 8; rr[0] = e0; rr[1] = e1; rr[2] = (int)p0; rr[3] = (int)p1; rr[4] = __builtin_bit_cast(int, s1 * inv); rr[5] = __builtin_bit_cast(int, s2 * inv);
        }
    }
}

__device__ __forceinline__ int expert_prefix(const Frame& F, int l, LAS int* ps) {
    const Args a = load_args(F.lds);
    const unsigned* cnt = (const unsigned*)(a.ws + WS_CTL) + CW_CNT + l * 16;
    __syncthreads();
    if (F.tid == 0) { int acc = 0; for (int e = 0; e < 16; ++e) { ps[e] = acc; const int c = (int)__hip_atomic_load(cnt + e, __ATOMIC_RELAXED, __HIP_MEMORY_SCOPE_AGENT); acc += ((c + 255) >> 8) << 8; } ps[16] = acc; }
    __syncthreads();
    return ps[16] >> 8;
}

__device__ __forceinline__ void phase_gather(const Frame& F, int l) {
    const Args a = load_args(F.lds);
    const bf16* H = (const bf16*)(a.ws + WS_H); bf16* XG = (bf16*)(a.ws + WS_XG);
    int* route = (int*)(a.ws + WS_ROUTE);
    LAS int* ps = (LAS int*)(F.lds + LDS_TILE_E);
    (void)expert_prefix(F, l, ps);
    const int rows = (l == 0) ? MA : ML;
    for (int r = F.gw; r < rows; r += F.NGW) {
        int* rr = route + (size_t)r * 8;
        const int e0 = rr[0], e1 = rr[1], p0 = rr[2], p1 = rr[3];
        const int d0 = ps[e0] + p0, d1 = ps[e1] + p1;
        const v4u* src = (const v4u*)(H + (size_t)r * D);
        const v4u x0 = src[F.lane], x1 = src[64 + F.lane];
        v4u* o0 = (v4u*)(XG + (size_t)d0 * D); v4u* o1 = (v4u*)(XG + (size_t)d1 * D);
        o0[F.lane] = x0; o0[64 + F.lane] = x1; o1[F.lane] = x0; o1[64 + F.lane] = x1;
        if (F.lane == 0) { rr[6] = d0; rr[7] = d1; }
    }
}

__device__ __forceinline__ int moe_tiles(const Frame& F, int l) {
    LAS int* ps = (LAS int*)(F.lds + LDS_TILE_E); LAS int* te = ps + 32;
    const int T = expert_prefix(F, l, ps);
    for (int t = F.tid; t < T; t += NT) { int e = 0;
#pragma unroll
        for (int q = 1; q < 16; ++q) if ((ps[q] >> 8) <= t) e = q;
        te[t] = e; }
    __syncthreads();
    return T;
}

__device__ __forceinline__ void phase_combine(const Frame& F, int l) {
    const Args a = load_args(F.lds);
    const float* mod = (const float*)(a.ws + WS_MOD) + (size_t)l * 5 * 6144; bf16* H = (bf16*)(a.ws + WS_H);
    const float* ctxn = (const float*)(a.ws + WS_CTXN); const bf16* Y = (const bf16*)(a.ws + WS_Y);
    const int* route = (const int*)(a.ws + WS_ROUTE);
    const int rows = (l == 0) ? MA : ML;
    for (int r = F.gw; r < rows; r += F.NGW) {
        const bool lat = r < ML;
        const float* src = lat ? a.out + (size_t)r * D : ctxn + (size_t)(r - ML) * D;
        const int j = lat ? (r >> 12) : 4;
        const int* rr = route + (size_t)r * 8;
        const float w0 = __builtin_bit_cast(float, rr[4]), w1 = __builtin_bit_cast(float, rr[5]);
        const bf16* y0 = Y + (size_t)rr[6] * D; const bf16* y1 = Y + (size_t)rr[7] * D;
        const float* g2 = mod + (size_t)j * 6144 + 5120;
        f32x4 v[4];
#pragma unroll
        for (int q = 0; q < 4; ++q) { const int k = 4 * F.lane + 256 * q;
            const f32x4 xv = *(const f32x4*)(src + k), gg = *(const f32x4*)(g2 + k);
            const v2u a0 = *(const v2u*)(y0 + k), a1 = *(const v2u*)(y1 + k);
            f32x4 yy;
            yy.x = w0 * pg8::bf_lo(a0.x) + w1 * pg8::bf_lo(a1.x); yy.y = w0 * pg8::bf_hi(a0.x) + w1 * pg8::bf_hi(a1.x);
            yy.z = w0 * pg8::bf_lo(a0.y) + w1 * pg8::bf_lo(a1.y); yy.w = w0 * pg8::bf_hi(a0.y) + w1 * pg8::bf_hi(a1.y);
            v[q] = xv + gg * yy;
            if (lat) *(f32x4*)(a.out + (size_t)r * D + k) = v[q]; }
        if (l == 0) { const float* m1 = (const float*)(a.ws + WS_MOD) + (size_t)(5 + j) * 6144;
            norm_mod_store(v, a.norm1_g + 1024, m1, m1 + 1024, H + (size_t)r * D, F.lane); }
    }
}

#define XB_TMO      128
#define XB_XCNT(j)  (256  + 64 * (j))
#define XB_XSUB(j)  (1280 + 64 * (j))
#define XB_XGEN(j)  (2304 + 64 * (j))
#define XB_TOP      3328
#define XB_TOPGEN   3392
#define XCD_BAR_WORDS 3456
#define XB_SPIN_CAP (1u << 18)
__device__ __forceinline__ unsigned xb_ld(unsigned* p)              { return __hip_atomic_load(p, __ATOMIC_RELAXED, __HIP_MEMORY_SCOPE_AGENT); }
__device__ __forceinline__ unsigned xb_add(unsigned* p, unsigned v) { return __hip_atomic_fetch_add(p, v, __ATOMIC_RELAXED, __HIP_MEMORY_SCOPE_AGENT); }
__device__ __forceinline__ unsigned xb_xcc_id() { return (unsigned)__builtin_amdgcn_s_getreg((3 << 11) | 20) & 0xFu; }
#define XB_SPIN(cond, bar) do { unsigned _sp = 0; while (cond) { __builtin_amdgcn_s_sleep(1); \
    if ((++_sp & 255u) == 0u) { if (xb_ld(&(bar)[XB_TMO])) break; if (_sp > XB_SPIN_CAP) { atomicAdd(&(bar)[XB_TMO], 1u); break; } } } } while (0)
struct XcdBarrier { unsigned* bar; unsigned x; volatile LAS unsigned* st; };
__device__ __forceinline__ XcdBarrier xcd_barrier_post(unsigned* bar, volatile LAS unsigned* st) {
    XcdBarrier b; b.bar = bar; b.x = xb_xcc_id(); b.st = st;
    if (threadIdx.x == 0) (void)xb_add(&bar[XB_XCNT(b.x)], 1u);
    return b;
}
__device__ __forceinline__ void xcd_barrier_complete(unsigned* bar, unsigned x, unsigned& nloc, unsigned& nx) {
    const unsigned G = gridDim.x * gridDim.y * gridDim.z;
    unsigned sum, cnt, mine, sp = 0u;
    for (;;) {
        sum = 0u; cnt = 0u; mine = 0u;
#pragma unroll
        for (unsigned j = 0; j < 16; ++j) { const unsigned c = xb_ld(&bar[XB_XCNT(j)]); sum += c; cnt += (c > 0u) ? 1u : 0u; mine = (j == x) ? c : mine; }
        if (sum == G) break;
        __builtin_amdgcn_s_sleep(1);
        if ((++sp & 255u) == 0u) { if (xb_ld(&bar[XB_TMO])) break; if (sp > XB_SPIN_CAP) { atomicAdd(&bar[XB_TMO], 1u); break; } }
    }
    nloc = mine > 0u ? mine : 1u; nx = cnt > 0u ? cnt : 1u;
}
__device__ __forceinline__ void xcd_barrier(const XcdBarrier& b) {
    asm volatile("s_waitcnt vmcnt(0)" ::: "memory");
    __syncthreads();
    if (threadIdx.x == 0) {
        unsigned* bar = b.bar;
        __builtin_amdgcn_s_waitcnt(0);
        unsigned nloc = b.st[0], nx = b.st[1];
        if (nloc == 0u) { xcd_barrier_complete(bar, b.x, nloc, nx); b.st[0] = nloc; b.st[1] = nx; }
        const unsigned old = xb_add(&bar[XB_XSUB(b.x)], 1u);
        const unsigned gen = old / nloc;
        if (old + 1u == (gen + 1u) * nloc) {
            __builtin_amdgcn_fence(__ATOMIC_RELEASE, "agent");
            asm volatile("s_waitcnt vmcnt(0)" ::: "memory");
            const unsigned og = xb_add(&bar[XB_TOP], 1u);
            const unsigned tg = og / nx;
            if (og + 1u == (tg + 1u) * nx) xb_add(&bar[XB_TOPGEN], 1u);
            else XB_SPIN(xb_ld(&bar[XB_TOPGEN]) == tg, bar);
            __builtin_amdgcn_fence(__ATOMIC_ACQUIRE, "agent");
            xb_add(&bar[XB_XGEN(b.x)], 1u);
            asm volatile("s_waitcnt vmcnt(0)" ::: "memory");
        } else {
            XB_SPIN(xb_ld(&bar[XB_XGEN(b.x)]) == gen, bar);
            __builtin_amdgcn_fence(__ATOMIC_ACQUIRE, "agent");
            asm volatile("s_waitcnt vmcnt(0)" ::: "memory");
        }
    }
    __syncthreads();
}

namespace pg8 {
enum { EM_PLAIN = 0, EM_IN = 1, EM_MERGE = 2, EM_OUT = 3, EM_MOE1 = 4 };
struct EpiAll {
    static constexpr bool PERM = true, AFTER_DRAIN = false;
    int mode, l, sub; LAS unsigned char* lds;
    __device__ __forceinline__ void operator()(const f32x4 (&acc)[2][2][4][2], const Unit& u, int wr, int wc, int fr, int fq) const {
        asm volatile("" : "+v"(fr), "+v"(fq));
        unsigned char* ws = (unsigned char*)ldp(lds, 23);
        bf16* Hb = (bf16*)(ws + WS_H); bf16* Pb = (bf16*)(ws + WS_P);
        switch (mode) {
            case EM_PLAIN: { const EpiPlain e{(bf16*)(ws + WS_Y), D}; e(acc, u, wr, wc, fr, fq); } break;
            case EM_IN:    { const EpiIn e{Pb, INW, (const float*)ldp(lds, 8) + l * 64, (const float*)ldp(lds, 9) + l * 64, (const float2*)(ws + WS_ROPE), 64}; e(acc, u, wr, wc, fr, fq); } break;
            case EM_MERGE: { const EpiMerge e{Hb, Pb, INW, COL_G + sub * 1024, sub != 0 ? 1 : 0}; e(acc, u, wr, wc, fr, fq); } break;
            case EM_OUT:   { float* out = (float*)ldp(lds, 22); const float* mod = (const float*)(ws + WS_MOD) + (size_t)l * 5 * 6144;
                             const EpiOut e{l == 0 ? (const float*)ldp(lds, 0) : (const float*)out, out, (const float*)ldp(lds, 2), (float*)(ws + WS_CTXN), mod + 2048}; e(acc, u, wr, wc, fr, fq); } break;
            default:       { const EpiMoe1 e{(bf16*)(ws + WS_ACT)}; e(acc, u, wr, wc, fr, fq); } break;
        }
    }
};
}

constexpr int N_PHASES = 2 + 9 * DEPTH;
__global__ void __launch_bounds__(NT, 2) mk_fwd(Args a) {
    extern __shared__ __attribute__((aligned(16))) unsigned char lds_raw[];
    LAS unsigned char* const lds0 = (LAS unsigned char*)lds_raw;
    volatile LAS unsigned* MISC = (volatile LAS unsigned*)(lds0 + LDS_MISC);
    if (threadIdx.x < 64) MISC[threadIdx.x] = 0u;
    if (threadIdx.x < 24) { const unsigned long long* ap = (const unsigned long long*)&a; ((LAS unsigned long long*)(lds0 + LDS_ATAB))[threadIdx.x] = ap[threadIdx.x]; }
    const int lo = a.ph_lo, hi = a.ph_hi;
    unsigned* barw = (unsigned*)(a.ws + WS_CTL) + CW_BAR;
    __syncthreads();
    XcdBarrier bar; bar.bar = barw; bar.x = 0; bar.st = nullptr;
    if (hi - lo > 1) bar = xcd_barrier_post(barw, MISC + 8);
    int ph = lo, sub = 0;
#pragma unroll 1
    while (ph < hi) {
        int tid_o = threadIdx.x, bid_o = blockIdx.x, grid_o = gridDim.x;
        asm volatile("" : "+v"(tid_o)); asm volatile("" : "+s"(bid_o), "+s"(grid_o));
        Frame F;
        F.lds = lds0;
        F.tid = tid_o; F.lane = F.tid & 63; F.wave = __builtin_amdgcn_readfirstlane(F.tid >> 6);
        F.G = grid_o; F.bid = bid_o; F.gw = bid_o * NWAVES + F.wave; F.NGW = F.G * NWAVES;
        const int l = ph < 2 ? 0 : (ph - 2) / 9, k = ph < 2 ? -1 : (ph - 2) % 9;
        unsigned char* ws = (unsigned char*)ldp(F.lds, 23);
        bool isg = false; int nsub = 1;
        pg8::Gemm g{nullptr, nullptr, 0, 0, 0}; pg8::Order S; S.init(1, 1, F.G, F.bid); pg8::EpiAll E{0, l, sub, F.lds};
        if (ph == 0) phase_prologue(F);
        else if (ph == 1) phase_norm_a0(F);
        else if (k == 0) {
            isg = true; g.A = (const bf16*)(ws + WS_H); g.Bt = (const bf16*)(ws + WS_WIN); g.K = D;
            S.init(l == 0 ? 68 : 64, 22, F.G, F.bid);
            if (l != 0) { S.exM0 = 64; S.exN = 4; S.exPn0 = 3; S.nExtra = 16; }
            E.mode = pg8::EM_IN;
        } else if (k == 1) { phase_conv(F, l); phase_fourier_simple(F, l); phase_attn_simple(F, l); }
        else if (k == 2) {
            isg = true; nsub = 3; S.init(l == 0 ? 68 : 64, 4, F.G, F.bid);
            E.mode = pg8::EM_MERGE;
            if (sub == 0) { g.A = (const bf16*)(ws + WS_FY); g.Bt = (const bf16*)(ws + WS_WF); g.K = 512; }
            else if (sub == 1) { g.A = (const bf16*)(ws + WS_ATT); g.Bt = (const bf16*)(ws + WS_WNA); g.K = 512; }
            else { g.A = (const bf16*)(ws + WS_YCV); g.Bt = (const bf16*)(ws + WS_WCV); g.K = 256; }
        } else if (k == 3) {
            isg = true; S.init(l == 0 ? 68 : 64, 4, F.G, F.bid);
            g.A = (const bf16*)(ws + WS_H); g.Bt = (const bf16*)(ws + WS_WO); g.K = D;
            E.mode = pg8::EM_OUT;
        } else if (k == 4) phase_route(F, l);
        else if (k == 5) phase_gather(F, l);
        else if (k == 6 || k == 7) {
            isg = true; const int T = moe_tiles(F, l);
            S.moeUnits = T * 4; S.tile_e = (const LAS int*)(F.lds + LDS_TILE_E) + 32;
            if (k == 6) { g.A = (const bf16*)(ws + WS_XG); g.Bt = (const bf16*)(ws + WS_W13); g.K = D; E.mode = pg8::EM_MOE1; }
            else { g.A = (const bf16*)(ws + WS_ACT); g.Bt = (const bf16*)(ws + WS_W2); g.K = DE; E.mode = pg8::EM_PLAIN; }
        } else { phase_combine(F, l); if (l + 1 < DEPTH) convert_weights(F, l + 1); }
        if (isg) pg8::gemm_phase<pg8::EpiAll, pg8::Order, true, true>(F.lds, g, S, E);
        if (sub + 1 < nsub) { ++sub; continue; }
        sub = 0; ++ph;
        if (ph < hi) xcd_barrier(bar);
    }
}

#ifndef MK_SINGLE
#define MK_SINGLE 0
#endif
extern "C" void kernel_launch(void* const* d_in, const int* in_sizes, int n_in, void* d_out, int out_size, void* d_ws, size_t ws_size, hipStream_t stream) {
    static int grid = 0;
    if (grid == 0) {
        if (n_in != 22 || out_size != ML * D || ws_size < WS_END) { fprintf(stderr, "kernel_launch: unexpected shapes (n_in %d out %d ws %zu need %zu)\n", n_in, out_size, ws_size, (size_t)WS_END); grid = -1; return; }
        int dev = 0, cus = 0;
        if (hipGetDevice(&dev) != hipSuccess || hipDeviceGetAttribute(&cus, hipDeviceAttributeMultiprocessorCount, dev) != hipSuccess) { grid = -1; return; }
        if (hipFuncSetAttribute((const void*)mk_fwd, hipFuncAttributeMaxDynamicSharedMemorySize, LDS_BYTES) != hipSuccess) { fprintf(stderr, "kernel_launch: hipFuncSetAttribute failed\n"); grid = -1; return; }
        int per_cu = 0;
        if (hipOccupancyMaxActiveBlocksPerMultiprocessor(&per_cu, (const void*)mk_fwd, NT, LDS_BYTES) != hipSuccess || per_cu < 1) fprintf(stderr, "kernel_launch: occupancy query says %d\n", per_cu);
        (void)hipGetLastError();
        grid = cus;
    }
    if (grid < 0) return;
    (void)hipMemsetAsync((char*)d_ws + WS_CTL, 0, CTL_ZERO_BYTES, stream);
    Args a{};
    const float** ap = (const float**)&a;
    for (int i = 0; i < 22; ++i) ap[i] = (const float*)d_in[i];
    a.out = (float*)d_out; a.ws = (unsigned char*)d_ws;
#if MK_SINGLE
    a.ph_lo = 0; a.ph_hi = N_PHASES;
    hipLaunchKernelGGL(mk_fwd, dim3(grid), dim3(NT), LDS_BYTES, stream, a);
#else
    for (int p = 0; p < N_PHASES; ++p) { a.ph_lo = p; a.ph_hi = p + 1; hipLaunchKernelGGL(mk_fwd, dim3(grid), dim3(NT), LDS_BYTES, stream, a); }
#endif
}
```

```cpp
#include <hip/hip_runtime.h>
#include <cstdio>
#include <cstdint>

namespace pg8 {
#define PG8_LAS __attribute__((address_space(3)))
typedef unsigned short bf16_t;
typedef short bf16x8 __attribute__((ext_vector_type(8)));
typedef float f32x4 __attribute__((ext_vector_type(4)));
typedef unsigned u32x4 __attribute__((ext_vector_type(4)));
typedef unsigned u32x2 __attribute__((ext_vector_type(2)));
constexpr int BM = 256, BK = 64, HALF = 128, HTB = HALF * BK * 2  , STAGE_BYTES = 8 * HTB, NXCD = 8, WGM = 8;

__host__ __device__ __forceinline__ int lds_byte(int r, int c) { const int st = (r >> 4) * 2 + (c >> 5), rr = r & 15, cc = c & 31, ob = rr * 64 + cc * 2; return st * 1024 + (ob ^ (((ob >> 9) & 1) << 5)); }
__host__ __device__ __forceinline__ void stage_rc(int b, int& R, int& C) { const int st = b / 1024, sb = b % 1024, swz = sb ^ (((sb >> 9) & 1) << 5); R = (st >> 1) * 16 + swz / 64; C = (st & 1) * 32 + (swz % 64) / 2; }
__host__ __device__ __forceinline__ int perm32(int rho) { const int n = rho >> 4, i = rho & 15; return 8 * (i >> 2) + 4 * n + (i & 3); }

struct Unit { int pm, pn, pb; };
struct Gemm { const bf16_t* A; const bf16_t* Bt; int M, N, K; };

struct Order {
    int nM, nN, nwg, G, c, exM0, exN, exPn0, nExtra, moeUnits; const PG8_LAS int* tile_e;
    __device__ void init(int nM_, int nN_, int G_, int c_) { nM = nM_; nN = nN_; nwg = nM * nN; G = G_; c = c_; exM0 = 0; exN = 1; exPn0 = 0; nExtra = 0; moeUnits = -1; tile_e = nullptr; }
    __device__ bool next(int i, Unit& u) const {
        const long L = (long)i * G + c;
        if (moeUnits >= 0) { if (L >= moeUnits) return false; const int t = (int)L >> 2; u.pm = t; u.pn = (int)L & 3; u.pb = tile_e[t] * 4 + u.pn; return true; }
        if (L >= nwg) { const int x = (int)(L - nwg); if (x >= nExtra) return false; u.pm = exM0 + x / exN; u.pn = exPn0 + x % exN; u.pb = u.pn; return true; }
        int wgid = (int)L; { const int q = nwg / NXCD, r = nwg % NXCD, xcd = wgid % NXCD, off = wgid / NXCD; wgid = (xcd < r ? xcd * (q + 1) : r * (q + 1) + (xcd - r) * q) + off; }
        const int nig = WGM * nN, gid = wgid / nig, fm = gid * WGM, gsz = (nM - fm) < WGM ? (nM - fm) : WGM;
        u.pm = fm + ((wgid % nig) % gsz); u.pn = (wgid % nig) / gsz; u.pb = u.pn; return true;
    }
    __device__ __forceinline__ void a_ready(const Unit&) const {}
    __device__ __forceinline__ void done(const Unit&) const {}
};

__device__ __forceinline__ unsigned cvt_pk_bf16(float lo, float hi) { unsigned r; asm volatile("v_cvt_pk_bf16_f32 %0, %1, %2" : "=v"(r) : "v"(lo), "v"(hi)); return r; }
__device__ __forceinline__ float bf_lo(unsigned w) { return __builtin_bit_cast(float, w << 16); }
__device__ __forceinline__ float bf_hi(unsigned w) { return __builtin_bit_cast(float, w & 0xffff0000u); }
__device__ __forceinline__ float sigmoidf_(float v) { return __builtin_amdgcn_rcpf(1.0f + __expf(-v)); }
__device__ __forceinline__ u32x4 pack8(const f32x4& v0, const f32x4& v1) { u32x4 w; w.x = cvt_pk_bf16(v0[0], v0[1]); w.y = cvt_pk_bf16(v0[2], v0[3]); w.z = cvt_pk_bf16(v1[0], v1[1]); w.w = cvt_pk_bf16(v1[2], v1[3]); return w; }

struct EpiPlain {
    static constexpr bool PERM = true, AFTER_DRAIN = false;
    bf16_t* O; int ldc;
    __device__ __forceinline__ void operator()(const f32x4 (&acc)[2][2][4][2], const Unit& u, int wr, int wc, int fr, int fq) const {
        const int row0 = u.pm * BM + wr * 64 + fr, col0 = u.pn * BM + wc * 32 + 8 * fq;
#pragma unroll
        for (int ai = 0; ai < 2; ++ai)
#pragma unroll
            for (int m = 0; m < 4; ++m) { bf16_t* rowp = O + (size_t)(row0 + ai * HALF + m * 16) * ldc + col0;
#pragma unroll
                for (int bj = 0; bj < 2; ++bj) *(u32x4*)(rowp + bj * HALF) = pack8(acc[ai][bj][m][0], acc[ai][bj][m][1]); }
    }
};

struct EpiIn {
    static constexpr bool PERM = true, AFTER_DRAIN = false;
    bf16_t* P; int ldc; const float* qg; const float* kg; const float2* rope; int latent_tiles;
    __device__ __forceinline__ void operator()(const f32x4 (&acc)[2][2][4][2], const Unit& u, int wr, int wc, int fr, int fq) const {
        const int pn = u.pn;
        const int row0 = u.pm * BM + wr * 64 + fr;
        if (pn >= 1 && pn <= 4) {
            const float* g = (pn <= 2) ? qg : kg;
            f32x4 gv[2][2];
#pragma unroll
            for (int bj = 0; bj < 2; ++bj)
#pragma unroll
                for (int n = 0; n < 2; ++n) gv[bj][n] = *(const f32x4*)(g + 32 * bj + 8 * fq + 4 * n);
            const bool lat = u.pm < latent_tiles;
#pragma unroll
            for (int ai = 0; ai < 2; ++ai)
#pragma unroll
                for (int m = 0; m < 4; ++m) {
                    float ss = 0.f;
#pragma unroll
                    for (int bj = 0; bj < 2; ++bj)
#pragma unroll
                        for (int n = 0; n < 2; ++n) { const f32x4 x = acc[ai][bj][m][n]; ss += (x[0] * x[0] + x[1] * x[1]) + (x[2] * x[2] + x[3] * x[3]); }
                    ss += __shfl_xor(ss, 16); ss += __shfl_xor(ss, 32);
                    const float rstd = __builtin_amdgcn_rsqf(ss * (1.0f / 64.0f) + 1e-6f);
                    f32x4 y[2][2];
#pragma unroll
                    for (int bj = 0; bj < 2; ++bj)
#pragma unroll
                        for (int n = 0; n < 2; ++n) y[bj][n] = acc[ai][bj][m][n] * rstd * gv[bj][n];
                    if (lat) {
                        const int pos = (fq < 2) ? ((4 * u.pm + 2 * ai + wr) & 63) : (16 * m + fr);
                        const float2* cs = rope + pos * 16 + 8 * (fq & 1);
#pragma unroll
                        for (int n = 0; n < 2; ++n)
#pragma unroll
                            for (int i = 0; i < 4; ++i) { const float2 c = cs[4 * n + i]; const float x1 = y[0][n][i], x2 = y[1][n][i]; y[0][n][i] = x1 * c.x - x2 * c.y; y[1][n][i] = x2 * c.x + x1 * c.y; }
                    }
                    bf16_t* rowp = P + (size_t)(row0 + ai * HALF + m * 16) * ldc + pn * BM + 64 * wc + 8 * fq;
#pragma unroll
                    for (int bj = 0; bj < 2; ++bj) *(u32x4*)(rowp + 32 * bj) = pack8(y[bj][0], y[bj][1]);
                }
        } else {
            const bool gate = pn >= 10;
            const int col0 = pn * BM + wc * 32 + 8 * fq;
#pragma unroll
            for (int ai = 0; ai < 2; ++ai)
#pragma unroll
                for (int m = 0; m < 4; ++m) { bf16_t* rowp = P + (size_t)(row0 + ai * HALF + m * 16) * ldc + col0;
#pragma unroll
                    for (int bj = 0; bj < 2; ++bj) { f32x4 v0 = acc[ai][bj][m][0], v1 = acc[ai][bj][m][1];
                        if (gate) {
#pragma unroll
                            for (int i = 0; i < 4; ++i) { v0[i] = sigmoidf_(v0[i]); v1[i] = sigmoidf_(v1[i]); } }
                        *(u32x4*)(rowp + bj * HALF) = pack8(v0, v1); } }
        }
    }
};

struct EpiMerge {
    static constexpr bool PERM = true, AFTER_DRAIN = false;
    bf16_t* MG; const bf16_t* P; int ldp; int goff; int accum;
    __device__ __forceinline__ void operator()(const f32x4 (&acc)[2][2][4][2], const Unit& u, int wr, int wc, int fr, int fq) const {
        const int row0 = u.pm * BM + wr * 64 + fr, col0 = u.pn * BM + wc * 32 + 8 * fq;
#pragma unroll
        for (int ai = 0; ai < 2; ++ai)
#pragma unroll
            for (int m = 0; m < 4; ++m) { const size_t row = (size_t)(row0 + ai * HALF + m * 16);
#pragma unroll
                for (int bj = 0; bj < 2; ++bj) {
                    const u32x4 gw = *(const u32x4*)(P + row * ldp + goff + col0 + bj * HALF);
                    f32x4 v0 = acc[ai][bj][m][0], v1 = acc[ai][bj][m][1];
                    v0[0] *= bf_lo(gw.x); v0[1] *= bf_hi(gw.x); v0[2] *= bf_lo(gw.y); v0[3] *= bf_hi(gw.y);
                    v1[0] *= bf_lo(gw.z); v1[1] *= bf_hi(gw.z); v1[2] *= bf_lo(gw.w); v1[3] *= bf_hi(gw.w);
                    bf16_t* op = MG + row * 1024 + col0 + bj * HALF;
                    if (accum) { const u32x4 o = *(const u32x4*)op;
                        v0[0] += bf_lo(o.x); v0[1] += bf_hi(o.x); v0[2] += bf_lo(o.y); v0[3] += bf_hi(o.y);
                        v1[0] += bf_lo(o.z); v1[1] += bf_hi(o.z); v1[2] += bf_lo(o.w); v1[3] += bf_hi(o.w); }
                    *(u32x4*)op = pack8(v0, v1); } }
    }
};

struct EpiOut {
    static constexpr bool PERM = true, AFTER_DRAIN = false;
    const float* baseL; float* outL; const float* baseC; float* outC; const float* gate;
    __device__ __forceinline__ void operator()(const f32x4 (&acc)[2][2][4][2], const Unit& u, int wr, int wc, int fr, int fq) const {
        const int col0 = u.pn * BM + wc * 32 + 8 * fq;
        const bool lat = u.pm < 64;
        const int j = lat ? (u.pm >> 4) : 4;
        const float* base = lat ? baseL : baseC; float* out = lat ? outL : outC;
        const int row0 = (lat ? u.pm : (u.pm - 64)) * BM + wr * 64 + fr;
        f32x4 gv[2][2];
#pragma unroll
        for (int bj = 0; bj < 2; ++bj)
#pragma unroll
            for (int n = 0; n < 2; ++n) gv[bj][n] = *(const f32x4*)(gate + (size_t)j * 6144 + col0 + bj * HALF + n * 4);
#pragma unroll
        for (int ai = 0; ai < 2; ++ai)
#pragma unroll
            for (int m = 0; m < 4; ++m) { const size_t off = (size_t)(row0 + ai * HALF + m * 16) * 1024 + col0;
#pragma unroll
                for (int bj = 0; bj < 2; ++bj)
#pragma unroll
                    for (int n = 0; n < 2; ++n) { const f32x4 b = *(const f32x4*)(base + off + bj * HALF + n * 4);
                        *(f32x4*)(out + off + bj * HALF + n * 4) = b + gv[bj][n] * acc[ai][bj][m][n]; } }
    }
};

struct EpiMoe1 {
    static constexpr bool PERM = true, AFTER_DRAIN = false;
    bf16_t* ACT;
    __device__ __forceinline__ void operator()(const f32x4 (&acc)[2][2][4][2], const Unit& u, int wr, int wc, int fr, int fq) const {
        const int row0 = u.pm * BM + wr * 64 + fr, col0 = u.pn * HALF + wc * 32 + 8 * fq;
#pragma unroll
        for (int ai = 0; ai < 2; ++ai)
#pragma unroll
            for (int m = 0; m < 4; ++m) { f32x4 v[2];
#pragma unroll
                for (int n = 0; n < 2; ++n)
#pragma unroll
                    for (int i = 0; i < 4; ++i) { const float a = acc[ai][0][m][n][i], b = acc[ai][1][m][n][i]; v[n][i] = a * sigmoidf_(a) * b; }
                *(u32x4*)(ACT + (size_t)(row0 + ai * HALF + m * 16) * 512 + col0) = pack8(v[0], v[1]); }
    }
};


template <class Epi, class Sched, bool ALIGN_EPI = false, bool SP2 = false>
__device__ __forceinline__ void gemm_phase(PG8_LAS unsigned char* lds, const Gemm g, const Sched& S, const Epi& E) {
    int tid_ = threadIdx.x; asm volatile("" : "+v"(tid_));
    const int tid = tid_, wid = __builtin_amdgcn_readfirstlane(tid >> 6), lane = tid & 63, wr = wid >> 2, wc = wid & 3, fr = lane & 15, fq = lane >> 4;
    const int K = g.K, nt = K / BK;
    unsigned voffA[2], voffB[2];
#pragma unroll
    for (int i = 0; i < 2; ++i) { int R, C; stage_rc(tid * 16 + i * 8192, R, C); const int Rb = Epi::PERM ? ((R & ~31) + perm32(R & 31)) : R;
        voffA[i] = (unsigned)(R * K + C) * 2u; voffB[i] = (unsigned)(Rb * K + C) * 2u; }
    const size_t kstep = (size_t)(BK * 2);
    const size_t hstep = (size_t)HALF * K * 2;
    const size_t tstep = 2 * hstep;
    const unsigned ldsw = (unsigned)wid * 1024u;
    const int aoff = lds_byte(wr * 64 + fr, fq * 8), boff = lds_byte(wc * 32 + fr, fq * 8);
#define PG8_SA(b, h) (((b) * 2 + (h)) * HTB)
#define PG8_SB(b, h) ((4 + (b) * 2 + (h)) * HTB)
#define PG8_STAGE(bufoff, gbase, voff) do { _Pragma("unroll") for (int _i = 0; _i < 2; ++_i) \
        __builtin_amdgcn_global_load_lds((const unsigned*)((const char*)(gbase) + (voff)[_i]), (PG8_LAS unsigned*)(lds + (bufoff) + ldsw + _i * 8192), 16, 0, 0); } while (0)
#define PG8_LDA(dst, b, h) do { _Pragma("unroll") for (int m = 0; m < 4; ++m) _Pragma("unroll") for (int k = 0; k < 2; ++k) dst[m][k] = *(const PG8_LAS bf16x8*)(lds + PG8_SA(b, h) + aoff + m * 2048 + k * 1024); } while (0)
#define PG8_LDB(dst, b, h) do { _Pragma("unroll") for (int n = 0; n < 2; ++n) _Pragma("unroll") for (int k = 0; k < 2; ++k) dst[n][k] = *(const PG8_LAS bf16x8*)(lds + PG8_SB(b, h) + boff + n * 2048 + k * 1024); } while (0)
#define PG8_MMA(ai, bj, At, Bt) do { __builtin_amdgcn_s_setprio(1); _Pragma("unroll") for (int m = 0; m < 4; ++m) _Pragma("unroll") for (int n = 0; n < 2; ++n) _Pragma("unroll") for (int k = 0; k < 2; ++k) \
        acc[ai][bj][m][n] = __builtin_amdgcn_mfma_f32_16x16x32_bf16(Bt[n][k], At[m][k], acc[ai][bj][m][n], 0, 0, 0); __builtin_amdgcn_s_setprio(0); } while (0)
#define PG8_WAIT_V(n) asm volatile("s_waitcnt vmcnt(" #n ")" ::: "memory")
#define PG8_WAIT_L(n) asm volatile("s_waitcnt lgkmcnt(" #n ")" ::: "memory")
#define PG8_BAR __builtin_amdgcn_s_barrier()
#define PG8_SCHED __builtin_amdgcn_sched_barrier(0)
    Unit cur, nxt; int ui = 0;
    if (!S.next(0, cur)) return;
    f32x4 acc[2][2][4][2];
#pragma unroll
    for (int a = 0; a < 2; ++a)
#pragma unroll
        for (int b = 0; b < 2; ++b)
#pragma unroll
            for (int m = 0; m < 4; ++m)
#pragma unroll
                for (int n = 0; n < 2; ++n) acc[a][b][m][n] = (f32x4){0.f, 0.f, 0.f, 0.f};
    bf16x8 At[4][2], B0[2][2], B1[2][2];
    const char* cA = (const char*)g.A + (size_t)cur.pm * tstep; const char* cB = (const char*)g.Bt + (size_t)cur.pb * tstep;
    S.a_ready(cur);
    if constexpr (SP2) {
        PG8_STAGE(PG8_SB(0, 0), cB, voffB); PG8_STAGE(PG8_SB(0, 1), cB + hstep, voffB); PG8_STAGE(PG8_SA(0, 0), cA, voffA); PG8_STAGE(PG8_SA(0, 1), cA + hstep, voffA);
        if (wr == 1) PG8_BAR;
        PG8_WAIT_V(2); PG8_BAR;
        PG8_STAGE(PG8_SB(1, 0), cB + kstep, voffB); PG8_STAGE(PG8_SA(1, 0), cA + kstep, voffA); PG8_STAGE(PG8_SB(1, 1), cB + hstep + kstep, voffB);
        PG8_WAIT_V(6); PG8_BAR;
    } else {
        PG8_STAGE(PG8_SB(0, 0), cB, voffB); PG8_STAGE(PG8_SA(0, 0), cA, voffA); PG8_STAGE(PG8_SB(0, 1), cB + hstep, voffB); PG8_STAGE(PG8_SA(0, 1), cA + hstep, voffA);
        if (wr == 1) PG8_BAR;
        PG8_WAIT_V(4); PG8_BAR;
        PG8_STAGE(PG8_SB(1, 0), cB + kstep, voffB); PG8_STAGE(PG8_SA(1, 0), cA + kstep, voffA); PG8_STAGE(PG8_SB(1, 1), cB + hstep + kstep, voffB);
        PG8_WAIT_V(6); PG8_BAR;
    }
    for (;;) {
        const bool has_next = S.next(ui + 1, nxt);
        const char* nA = has_next ? (const char*)g.A + (size_t)nxt.pm * tstep : cA; const char* nB = has_next ? (const char*)g.Bt + (size_t)nxt.pb * tstep : cB;
        for (int t = 0; t < nt; t += 2) {
            const bool last = (t == nt - 2);
            const char* a1 = cA + (size_t)(t + 1) * kstep;
            const char* a2 = last ? nA : cA + (size_t)(t + 2) * kstep; const char* b2 = last ? nB : cB + (size_t)(t + 2) * kstep;
            const char* a3 = a2 + kstep; const char* b3 = b2 + kstep;
            if (last && has_next) S.a_ready(nxt);
            if constexpr (SP2) {
            PG8_LDB(B0, 0, 0); PG8_LDB(B1, 0, 1); PG8_SCHED; PG8_LDA(At, 0, 0); PG8_STAGE(PG8_SA(1, 1), a1 + hstep, voffA);
            PG8_WAIT_V(8); PG8_WAIT_L(0); PG8_BAR; PG8_MMA(0, 0, At, B0); PG8_MMA(0, 1, At, B1); PG8_BAR; PG8_SCHED;
            PG8_LDA(At, 0, 1); PG8_STAGE(PG8_SB(0, 0), b2, voffB); PG8_STAGE(PG8_SB(0, 1), b2 + hstep, voffB); PG8_STAGE(PG8_SA(0, 0), a2, voffA);
            PG8_WAIT_V(8); PG8_WAIT_L(0); PG8_BAR; PG8_MMA(1, 0, At, B0); PG8_MMA(1, 1, At, B1); PG8_BAR; PG8_SCHED;
            PG8_LDB(B0, 1, 0); PG8_LDB(B1, 1, 1); PG8_SCHED; PG8_LDA(At, 1, 0); PG8_STAGE(PG8_SA(0, 1), a2 + hstep, voffA);
            PG8_WAIT_V(8); PG8_WAIT_L(0); PG8_BAR; PG8_MMA(0, 0, At, B0); PG8_MMA(0, 1, At, B1); PG8_BAR; PG8_SCHED;
            PG8_LDA(At, 1, 1); PG8_STAGE(PG8_SB(1, 0), b3, voffB); PG8_STAGE(PG8_SB(1, 1), b3 + hstep, voffB); PG8_STAGE(PG8_SA(1, 0), a3, voffA);
            PG8_WAIT_V(8); PG8_WAIT_L(0); PG8_BAR; PG8_MMA(1, 0, At, B0); PG8_MMA(1, 1, At, B1); PG8_BAR; PG8_SCHED;
            } else {
            PG8_LDB(B0, 0, 0); PG8_SCHED; PG8_LDA(At, 0, 0); PG8_STAGE(PG8_SA(1, 1), a1 + hstep, voffA);
            PG8_WAIT_L(8); PG8_BAR; PG8_WAIT_L(0); PG8_MMA(0, 0, At, B0); PG8_BAR; PG8_SCHED;
            PG8_LDB(B1, 0, 1); PG8_STAGE(PG8_SB(0, 0), b2, voffB);
            PG8_BAR; PG8_WAIT_L(0); PG8_MMA(0, 1, At, B1); PG8_BAR;
            PG8_LDA(At, 0, 1); PG8_STAGE(PG8_SA(0, 0), a2, voffA);
            PG8_BAR; PG8_WAIT_L(0); PG8_MMA(1, 0, At, B0); PG8_BAR; PG8_SCHED;
            PG8_STAGE(PG8_SB(0, 1), b2 + hstep, voffB);
            PG8_WAIT_V(6); PG8_BAR; PG8_MMA(1, 1, At, B1); PG8_BAR;
            PG8_LDB(B0, 1, 0); PG8_SCHED; PG8_LDA(At, 1, 0); PG8_STAGE(PG8_SA(0, 1), a2 + hstep, voffA);
            PG8_WAIT_L(8); PG8_BAR; PG8_WAIT_L(0); PG8_MMA(0, 0, At, B0); PG8_BAR; PG8_SCHED;
            PG8_LDB(B1, 1, 1); PG8_STAGE(PG8_SB(1, 0), b3, voffB);
            PG8_BAR; PG8_WAIT_L(0); PG8_MMA(0, 1, At, B1); PG8_BAR;
            PG8_LDA(At, 1, 1); PG8_STAGE(PG8_SA(1, 0), a3, voffA);
            PG8_BAR; PG8_WAIT_L(0); PG8_MMA(1, 0, At, B0); PG8_BAR; PG8_SCHED;
            PG8_STAGE(PG8_SB(1, 1), b3 + hstep, voffB);
            PG8_WAIT_V(6); PG8_BAR; PG8_MMA(1, 1, At, B1); PG8_BAR;
            }
        }
        if constexpr (ALIGN_EPI) { if (wr == 0) PG8_BAR; }
        if constexpr (!Epi::AFTER_DRAIN) { E(acc, cur, wr, wc, fr, fq); S.done(cur); }
        if (!has_next) break;
#pragma unroll
        for (int a = 0; a < 2; ++a)
#pragma unroll
            for (int b = 0; b < 2; ++b)
#pragma unroll
                for (int m = 0; m < 4; ++m)
#pragma unroll
                    for (int n = 0; n < 2; ++n) acc[a][b][m][n] = (f32x4){0.f, 0.f, 0.f, 0.f};
        cur = nxt; cA = nA; cB = nB; ++ui;
        if constexpr (ALIGN_EPI) { if (wr == 1) PG8_BAR; }
    }
    PG8_WAIT_V(0);
    if constexpr (!ALIGN_EPI) { if (wr == 0) PG8_BAR; }
    PG8_BAR;
    if constexpr (Epi::AFTER_DRAIN) { E.fused(acc, cur, wr, wc, fr, fq, lds, wid, lane); S.done(cur); }
#undef PG8_SA
#undef PG8_SB
#undef PG8_STAGE
#undef PG8_LDA
#undef PG8_LDB
#undef PG8_MMA
#undef PG8_WAIT_V
#undef PG8_WAIT_L
#undef PG8_BAR
#undef PG8_SCHED
}
}

#define GAS __attribute__((address_space(1)))
#define LAS __attribute__((address_space(3)))
typedef unsigned short bf16;
typedef unsigned v4u __attribute__((ext_vector_type(4)));
typedef unsigned v2u __attribute__((ext_vector_type(2)));
typedef float f32x4 __attribute__((ext_vector_type(4)));
typedef float f32x2 __attribute__((ext_vector_type(2)));
#define LDS_WAIT() asm volatile("s_waitcnt lgkmcnt(0)" ::: "memory")
#define VM_WAIT() asm volatile("s_waitcnt vmcnt(0)" ::: "memory")

constexpr int D = 1024, NB = 4, SEQ = 4096, CTXL = 256, INW = 5632, DEPTH = 2;
constexpr int ML = NB * SEQ, MC = NB * CTXL, MA = ML + MC;
constexpr int COL_F = 0, COL_Q = 256, COL_K = 768, COL_V = 1280, COL_CX = 1792, COL_CB = 2048, COL_CC = 2304, COL_G = 2560;
constexpr int NE = 16, DE = 512;
constexpr int XG_ROWS = 39168;
constexpr int NWAVES = 8, NT = 512;
constexpr int LDS_BYTES = 163840;
constexpr int LDS_TILE_E = 131072, LDS_MISC = 163840 - 256, LDS_ATAB = 163840 - 512;

constexpr size_t MiB = 1u << 20;
constexpr size_t WS_CTL = 0, CTL_ZERO_BYTES = 65536;
constexpr size_t WS_MOD = 1 * MiB;
constexpr size_t WS_ROPE = WS_MOD + 256 * 1024, WS_TW = WS_MOD + 320 * 1024;
constexpr size_t WS_WIN = 2 * MiB, WS_WF = 13 * MiB, WS_WNA = 14 * MiB, WS_WCV = 15 * MiB, WS_WO = 16 * MiB, WS_W13 = 18 * MiB, WS_W2 = 50 * MiB;
constexpr size_t WS_H = 66 * MiB;
constexpr size_t WS_ATT = 100 * MiB, WS_FY = 117 * MiB, WS_YCV = 134 * MiB, WS_CTXN = 143 * MiB, WS_ROUTE = 151 * MiB;
constexpr size_t WS_P = 152 * MiB;
constexpr size_t WS_XG = 152 * MiB, WS_ACT = 229 * MiB, WS_Y = 268 * MiB;
constexpr size_t WS_END = WS_Y + (size_t)XG_ROWS * 1024 * 2;
static_assert(WS_P + (size_t)MA * INW * 2 <= 340 * MiB && WS_XG + (size_t)XG_ROWS * 2048 <= WS_ACT && WS_ACT + (size_t)XG_ROWS * 1024 <= WS_Y, "ws map");
constexpr int CW_CNT = 64;
constexpr int CW_BAR = 4096;

__device__ __forceinline__ unsigned f2bf(float f) { unsigned u = __builtin_bit_cast(unsigned, f); return (u + 0x7fffu + ((u >> 16) & 1u)) >> 16; }
__device__ __forceinline__ unsigned pk2(float lo, float hi) { return f2bf(lo) | (f2bf(hi) << 16); }
__device__ __forceinline__ float bf2f(unsigned short h) { return __builtin_bit_cast(float, (unsigned)h << 16); }
__device__ __forceinline__ float wave_sum(float v) {
#pragma unroll
    for (int o = 1; o < 64; o <<= 1) v += __shfl_xor(v, o);
    return v;
}
__device__ __forceinline__ float wave_max(float v) {
#pragma unroll
    for (int o = 1; o < 64; o <<= 1) v = fmaxf(v, __shfl_xor(v, o));
    return v;
}

struct Args {
    const float *x, *c, *ctx, *c_ctx, *ada_w, *ada_b, *norm1_g, *w_in, *qn_g, *kn_g, *rpb, *conv_w, *w_f, *w_na, *w_cv, *w_o, *norm2_g, *router_w, *router_b, *w1, *w3, *w2;
    float* out; unsigned char* ws; int ph_lo, ph_hi;
};

struct Frame {
    LAS unsigned char* lds;
    int tid, lane, wave, G, bid, gw, NGW;
};

__device__ __forceinline__ unsigned long long ldp(LAS unsigned char* lds, int i) {
    const volatile LAS unsigned* t = (const volatile LAS unsigned*)(lds + LDS_ATAB);
    const unsigned lo = __builtin_amdgcn_readfirstlane(t[2 * i]), hi = __builtin_amdgcn_readfirstlane(t[2 * i + 1]);
    return ((unsigned long long)hi << 32) | lo;
}
__device__ __forceinline__ Args load_args(LAS unsigned char* lds) {
    Args a;
    a.x = (const float*)ldp(lds, 0); a.c = (const float*)ldp(lds, 1); a.ctx = (const float*)ldp(lds, 2); a.c_ctx = (const float*)ldp(lds, 3);
    a.ada_w = (const float*)ldp(lds, 4); a.ada_b = (const float*)ldp(lds, 5); a.norm1_g = (const float*)ldp(lds, 6); a.w_in = (const float*)ldp(lds, 7);
    a.qn_g = (const float*)ldp(lds, 8); a.kn_g = (const float*)ldp(lds, 9); a.rpb = (const float*)ldp(lds, 10); a.conv_w = (const float*)ldp(lds, 11);
    a.w_f = (const float*)ldp(lds, 12); a.w_na = (const float*)ldp(lds, 13); a.w_cv = (const float*)ldp(lds, 14); a.w_o = (const float*)ldp(lds, 15);
    a.norm2_g = (const float*)ldp(lds, 16); a.router_w = (const float*)ldp(lds, 17); a.router_b = (const float*)ldp(lds, 18);
    a.w1 = (const float*)ldp(lds, 19); a.w3 = (const float*)ldp(lds, 20); a.w2 = (const float*)ldp(lds, 21);
    a.out = (float*)ldp(lds, 22); a.ws = (unsigned char*)ldp(lds, 23); a.ph_lo = 0; a.ph_hi = 0;
    return a;
}

__device__ __forceinline__ void tr_tile(const float* Wp, int ldw, bf16* WTp, int ldo, LAS float* scr, int lane) {
#pragma unroll 8
    for (int i = 0; i < 32; ++i) { const int kk = 2 * i + (lane >> 5); scr[kk * 33 + (lane & 31)] = Wp[(size_t)kk * ldw + (lane & 31)]; }
    LDS_WAIT(); asm volatile("" ::: "memory");
    const int c = lane & 7;
#pragma unroll
    for (int j = 0; j < 4; ++j) { const int n = (lane >> 3) + 8 * j; const LAS float* s = scr + (8 * c) * 33 + n;
        v4u o; o.x = pk2(s[0 * 33], s[1 * 33]); o.y = pk2(s[2 * 33], s[3 * 33]); o.z = pk2(s[4 * 33], s[5 * 33]); o.w = pk2(s[6 * 33], s[7 * 33]);
        *(v4u*)(WTp + (size_t)n * ldo + 8 * c) = o; }
    LDS_WAIT(); asm volatile("" ::: "memory");
}

__device__ __forceinline__ void convert_weights(const Frame& F, int l) {
    const Args a = load_args(F.lds);
    LAS float* scr = (LAS float*)(F.lds + F.wave * 8448);
    unsigned char* ws = a.ws;
    bf16* WIN = (bf16*)(ws + WS_WIN); bf16* WNA = (bf16*)(ws + WS_WNA); bf16* WCV = (bf16*)(ws + WS_WCV); bf16* WO = (bf16*)(ws + WS_WO);
    bf16* W13 = (bf16*)(ws + WS_W13); bf16* W2 = (bf16*)(ws + WS_W2); bf16* WF = (bf16*)(ws + WS_WF);
    constexpr int I_IN = 16 * 176, I_NA = 8 * 32, I_CV = 4 * 32, I_O = 16 * 32, I_E1 = 16 * 256, I_E2 = 16 * 256;
    constexpr int NITEMS = I_IN + I_NA + I_CV + I_O + 2 * I_E1 + I_E2;
    for (int it = F.gw; it < NITEMS; it += F.NGW) {
        int r = it;
        if (r < I_IN) { const int kb = r / 176, nb = r % 176, n0 = 32 * nb, k0 = 64 * kb;
            int drow = n0;
            if (n0 >= COL_Q && n0 < COL_V) { const int pn = n0 >> 8, w = n0 & 255, wc = w >> 6, dd = w & 63; drow = pn * 256 + 128 * (dd >> 5) + 32 * wc + (dd & 31); }
            tr_tile(a.w_in + (size_t)l * D * INW + (size_t)k0 * INW + n0, INW, WIN + (size_t)drow * D + k0, D, scr, F.lane); continue; }
        r -= I_IN;
        if (r < I_NA) { const int kb = r / 32, nb = r % 32; tr_tile(a.w_na + (size_t)l * 512 * D + (size_t)(64 * kb) * D + 32 * nb, D, WNA + (size_t)(32 * nb) * 512 + 64 * kb, 512, scr, F.lane); continue; }
        r -= I_NA;
        if (r < I_CV) { const int kb = r / 32, nb = r % 32; tr_tile(a.w_cv + (size_t)l * 256 * D + (size_t)(64 * kb) * D + 32 * nb, D, WCV + (size_t)(32 * nb) * 256 + 64 * kb, 256, scr, F.lane); continue; }
        r -= I_CV;
        if (r < I_O) { const int kb = r / 32, nb = r % 32; tr_tile(a.w_o + (size_t)l * D * D + (size_t)(64 * kb) * D + 32 * nb, D, WO + (size_t)(32 * nb) * D + 64 * kb, D, scr, F.lane); continue; }
        r -= I_O;
        if (r < 2 * I_E1) { const int which = r / I_E1; r -= which * I_E1; const int e = r >> 8, q = r & 255, kb = q >> 4, nb = q & 15, n0 = 32 * nb;
            const float* W = (which ? a.w3 : a.w1) + ((size_t)(l * NE + e) * D + 64 * kb) * DE + n0;
            const int drow = (n0 >> 7) * 256 + which * 128 + (n0 & 127);
            tr_tile(W, DE, W13 + (size_t)e * D * D + (size_t)drow * D + 64 * kb, D, scr, F.lane); continue; }
        r -= 2 * I_E1;
        { const int e = r >> 8, q = r & 255, kb = q >> 5, nb = q & 31;
          tr_tile(a.w2 + ((size_t)(l * NE + e) * DE + 64 * kb) * D + 32 * nb, D, W2 + (size_t)e * D * DE + (size_t)(32 * nb) * DE + 64 * kb, DE, scr, F.lane); }
    }
    const float* wf = a.w_f + (size_t)l * 256 * D;
    for (int o = F.bid * NT + F.tid; o < 512 * 1024; o += F.G * NT) {
        const int n = o & 1023, kk = o >> 10, cc = kk & 63, g = (kk >> 6) & 3; const bool sn = kk >= 256;
        float s = 0.f;
        for (int m = 0; m < 64; ++m) { const int idx = (m * cc) & 63; float sv, cv; __sincosf((float)idx * 0.09817477042468103f, &sv, &cv);
            s += (sn ? sv : cv) * wf[(size_t)(g * 64 + m) * D + n]; }
        WF[(size_t)n * 512 + kk] = (bf16)f2bf(s * 0.125f);
    }
}

__device__ __forceinline__ void phase_prologue(const Frame& F) {
    const Args a = load_args(F.lds);
    float2* rope = (float2*)(a.ws + WS_ROPE); float2* tw = (float2*)(a.ws + WS_TW); float* mod = (float*)(a.ws + WS_MOD);
    const int gt = F.bid * NT + F.tid, GT = F.G * NT;
    for (int i = gt; i < 1024; i += GT) { const int pos = i >> 4, f = i & 15; const float inv = powf(10000.0f, -(float)f / 16.0f); const float ang = (float)pos * inv; rope[i] = make_float2(cosf(ang), sinf(ang)); }
    for (int i = gt; i < 4096; i += GT) { const float ang = (float)i * (6.283185307179586f / 4096.0f); tw[i] = make_float2(cosf(ang), sinf(ang)); }
    if (F.bid < 192) {
        LAS float* s = (LAS float*)(F.lds + 70000);
        LAS float* red = (LAS float*)(F.lds + 70000 + 20480);
        for (int i = F.tid; i < 5 * 1024; i += NT) { const int j = i >> 10, k = i & 1023; const float v = (j < 4) ? a.c[j * 1024 + k] : a.c_ctx[k]; s[i] = v / (1.0f + __expf(-v)); }
        __syncthreads();
        for (int it = F.bid; it < 192; it += F.G) {
            const int l = it / 96, n0 = (it % 96) * 64;
            float acc[5] = {0.f, 0.f, 0.f, 0.f, 0.f};
            const float* w = a.ada_w + ((size_t)l * 1024 + F.wave * 128) * 6144 + n0 + F.lane;
            for (int k = 0; k < 128; ++k) { const float wv = w[(size_t)k * 6144];
#pragma unroll
                for (int j = 0; j < 5; ++j) acc[j] += s[j * 1024 + F.wave * 128 + k] * wv; }
#pragma unroll
            for (int j = 0; j < 5; ++j) red[(F.wave * 5 + j) * 64 + F.lane] = acc[j];
            __syncthreads();
            if (F.tid < 320) { const int j = F.tid >> 6, ln = F.tid & 63; float t = a.ada_b[l * 6144 + n0 + ln];
                for (int w8 = 0; w8 < 8; ++w8) t += red[(w8 * 5 + j) * 64 + ln];
                mod[(size_t)(l * 5 + j) * 6144 + n0 + ln] = t; }
            __syncthreads();
        }
    }
    convert_weights(F, 0);
}

__device__ __forceinline__ void norm_mod_store(f32x4 (&v)[4], const float* g, const float* sh, const float* sc, bf16* orow, int lane) {
    float s = 0.f;
#pragma unroll
    for (int j = 0; j < 4; ++j) s += (v[j].x * v[j].x + v[j].y * v[j].y) + (v[j].z * v[j].z + v[j].w * v[j].w);
    const float rstd = 1.0f / sqrtf(wave_sum(s) * (1.0f / 1024.0f) + 1e-6f);
#pragma unroll
    for (int j = 0; j < 4; ++j) { const int k = 4 * lane + 256 * j;
        const f32x4 gg = *(const f32x4*)(g + k), ss = *(const f32x4*)(sh + k), cc = *(const f32x4*)(sc + k);
        const f32x4 y = v[j] * rstd * gg * (cc + 1.0f) + ss;
        v[j] = y;
        *(v2u*)(orow + k) = (v2u){pk2(y.x, y.y), pk2(y.z, y.w)}; }
}

__device__ __forceinline__ void phase_norm_a0(const Frame& F) {
    const Args a = load_args(F.lds);
    const float* mod = (const float*)(a.ws + WS_MOD); bf16* H = (bf16*)(a.ws + WS_H);
    for (int r = F.gw; r < MA; r += F.NGW) {
        const float* src = (r < ML) ? a.x + (size_t)r * D : a.ctx + (size_t)(r - ML) * D;
        const int j = (r < ML) ? (r >> 12) : 4;
        f32x4 v[4];
#pragma unroll
        for (int q = 0; q < 4; ++q) v[q] = *(const f32x4*)(src + 4 * F.lane + 256 * q);
        const float* m = mod + (size_t)j * 6144;
        norm_mod_store(v, a.norm1_g, m, m + 1024, H + (size_t)r * D, F.lane);
    }
}

__device__ __forceinline__ void phase_conv(const Frame& F, int l) {
    const Args a = load_args(F.lds);
    const bf16* P = (const bf16*)(a.ws + WS_P); bf16* Y = (bf16*)(a.ws + WS_YCV);
    const float* cw = a.conv_w + l * 3 * 256;
    const int rows = (l == 0) ? MA : ML;
    for (int o = F.bid * NT + F.tid; o < rows * 32; o += F.G * NT) {
        const int r = o >> 5, c0 = (o & 31) * 8;
        int tpos, len; if (r < ML) { tpos = r & 4095; len = 4096; } else { tpos = (r - ML) & 255; len = 256; }
        const bf16* pr = P + (size_t)r * INW;
        float u0[8], u1[8], u2[8], bg[8];
        { const v4u x = *(const v4u*)(pr + COL_CX + c0), c = *(const v4u*)(pr + COL_CC + c0), b = *(const v4u*)(pr + COL_CB + c0);
          const unsigned xs[4] = {x.x, x.y, x.z, x.w}, cs[4] = {c.x, c.y, c.z, c.w}, bs[4] = {b.x, b.y, b.z, b.w};
#pragma unroll
          for (int q = 0; q < 4; ++q) { u1[2 * q] = pg8::bf_lo(xs[q]) * pg8::bf_lo(cs[q]); u1[2 * q + 1] = pg8::bf_hi(xs[q]) * pg8::bf_hi(cs[q]); bg[2 * q] = pg8::bf_lo(bs[q]); bg[2 * q + 1] = pg8::bf_hi(bs[q]); } }
        if (tpos > 0) { const v4u x = *(const v4u*)(pr - INW + COL_CX + c0), c = *(const v4u*)(pr - INW + COL_CC + c0);
          const unsigned xs[4] = {x.x, x.y, x.z, x.w}, cs[4] = {c.x, c.y, c.z, c.w};
#pragma unroll
          for (int q = 0; q < 4; ++q) { u0[2 * q] = pg8::bf_lo(xs[q]) * pg8::bf_lo(cs[q]); u0[2 * q + 1] = pg8::bf_hi(xs[q]) * pg8::bf_hi(cs[q]); } }
        else {
#pragma unroll
          for (int q = 0; q < 8; ++q) u0[q] = 0.f; }
        if (tpos < len - 1) { const v4u x = *(const v4u*)(pr + INW + COL_CX + c0), c = *(const v4u*)(pr + INW + COL_CC + c0);
          const unsigned xs[4] = {x.x, x.y, x.z, x.w}, cs[4] = {c.x, c.y, c.z, c.w};
#pragma unroll
          for (int q = 0; q < 4; ++q) { u2[2 * q] = pg8::bf_lo(xs[q]) * pg8::bf_lo(cs[q]); u2[2 * q + 1] = pg8::bf_hi(xs[q]) * pg8::bf_hi(cs[q]); } }
        else {
#pragma unroll
          for (int q = 0; q < 8; ++q) u2[q] = 0.f; }
        float y[8];
#pragma unroll
        for (int q = 0; q < 8; ++q) y[q] = bg[q] * (cw[c0 + q] * u0[q] + cw[256 + c0 + q] * u1[q] + cw[512 + c0 + q] * u2[q]);
        *(v4u*)(Y + (size_t)r * 256 + c0) = (v4u){pk2(y[0], y[1]), pk2(y[2], y[3]), pk2(y[4], y[5]), pk2(y[6], y[7])};
    }
}

__device__ __forceinline__ void phase_attn_simple(const Frame& F, int l) {
    const Args a = load_args(F.lds);
    const bf16* P = (const bf16*)(a.ws + WS_P); bf16* ATT = (bf16*)(a.ws + WS_ATT);
    LAS bf16* Ks = (LAS bf16*)(F.lds);
    LAS bf16* Vs = (LAS bf16*)(F.lds + 67584);
    LAS float* pb = (LAS float*)(F.lds + 133120) + F.wave * 256;
    LAS float* st = (LAS float*)(F.lds + 141312) + F.wave * 8 * 66;
    const float* rpb = a.rpb + (size_t)l * 8 * 15 * 31;
    const int nItems = 2048 + (l == 0 ? 128 : 0);
    for (int it = F.bid; it < nItems; it += F.G) {
        int b, r = 0, h, qrow0, rs = 0; bool local;
        if (it < 2048) { b = it >> 9; r = (it >> 3) & 63; h = it & 7; qrow0 = b * 4096 + r * 64; local = true; rs = r - 4; rs = rs < 0 ? 0 : (rs > 56 ? 56 : rs); }
        else { const int j = it - 2048; b = j >> 5; h = (j >> 2) & 7; qrow0 = ML + b * 256 + (j & 3) * 64; local = false; }
        for (int i = F.lane; i < 8 * 66; i += 64) { const int q = i / 66, e = i % 66; st[i] = (e == 64) ? -1e30f : 0.f; }
        for (int stage = local ? 0 : 1; stage < 2; ++stage) {
            __syncthreads();
            const int nk = stage == 0 ? 512 : 256;
            const size_t krow0 = stage == 0 ? (size_t)b * 4096 + rs * 64 : (size_t)ML + b * 256;
            for (int i = F.tid; i < nk * 8; i += NT) { const int key = i >> 3, ch = i & 7;
                const bf16* src = P + (krow0 + key) * INW + h * 64 + ch * 8;
                const v4u kv = *(const v4u*)(src + COL_K), vv = *(const v4u*)(src + COL_V);
                LAS unsigned* kd = (LAS unsigned*)(Ks + key * 66 + ch * 8); kd[0] = kv.x; kd[1] = kv.y; kd[2] = kv.z; kd[3] = kv.w;
                *(LAS v4u*)(Vs + key * 64 + ch * 8) = vv; }
            __syncthreads();
            for (int q = 0; q < 8; ++q) {
                const int qi = F.wave * 8 + q;
                float qv[64];
                { const bf16* qp = P + (size_t)(qrow0 + qi) * INW + COL_Q + h * 64;
#pragma unroll
                  for (int c = 0; c < 8; ++c) { const v4u w = *(const v4u*)(qp + c * 8); const unsigned ws4[4] = {w.x, w.y, w.z, w.w};
#pragma unroll
                      for (int e = 0; e < 4; ++e) { qv[c * 8 + 2 * e] = pg8::bf_lo(ws4[e]); qv[c * 8 + 2 * e + 1] = pg8::bf_hi(ws4[e]); } } }
                int cs = qi - 8; cs = cs < 0 ? 0 : (cs > 48 ? 48 : cs);
                const int nch = stage == 0 ? 2 : 4;
                float sc[4]; float mx = -1e30f;
#pragma unroll
                for (int c = 0; c < 4; ++c) { sc[c] = -1e30f;
                    if (c < nch) {
                        int kidx; float bias = 0.f;
                        if (stage == 0) { const int i = c * 4 + (F.lane >> 4), kc = cs + (F.lane & 15); kidx = i * 64 + kc; bias = rpb[(h * 15 + (rs + i - r + 7)) * 31 + (kc - qi + 15)]; }
                        else kidx = c * 64 + F.lane;
                        const LAS unsigned* kp = (const LAS unsigned*)(Ks + kidx * 66);
                        float d = 0.f;
#pragma unroll
                        for (int e = 0; e < 32; ++e) { const unsigned w = kp[e]; d += qv[2 * e] * pg8::bf_lo(w) + qv[2 * e + 1] * pg8::bf_hi(w); }
                        sc[c] = d * 0.125f + bias; mx = fmaxf(mx, sc[c]); } }
                mx = wave_max(mx);
                const float m_old = st[q * 66 + 64], l_old = st[q * 66 + 65], o_old = st[q * 66 + F.lane];
                const float m_new = fmaxf(m_old, mx), alpha = __expf(m_old - m_new);
                float psum = 0.f;
#pragma unroll
                for (int c = 0; c < 4; ++c) if (c < nch) { const float p = __expf(sc[c] - m_new); psum += p; pb[c * 64 + F.lane] = p; }
                psum = wave_sum(psum);
                LDS_WAIT(); asm volatile("" ::: "memory");
                float o = o_old * alpha;
                const int nkq = nch * 64;
                for (int j = 0; j < nkq; ++j) {
                    int kidx; if (stage == 0) { const int c = j >> 6, ln = j & 63; kidx = (c * 4 + (ln >> 4)) * 64 + cs + (ln & 15); } else kidx = j;
                    o += pb[j] * bf2f(Vs[kidx * 64 + F.lane]); }
                st[q * 66 + F.lane] = o;
                if (F.lane == 0) { st[q * 66 + 64] = m_new; st[q * 66 + 65] = l_old * alpha + psum; }
                LDS_WAIT(); asm volatile("" ::: "memory");
            }
        }
        for (int q = 0; q < 8; ++q) { const int qi = F.wave * 8 + q; const float o = st[q * 66 + F.lane] / st[q * 66 + 65];
            ATT[(size_t)(qrow0 + qi) * 512 + h * 64 + F.lane] = (bf16)f2bf(o); }
        LDS_WAIT(); asm volatile("" ::: "memory");
    }
    __syncthreads();
}

typedef short v4i16_t __attribute__((ext_vector_type(4)));
typedef float f32x16 __attribute__((ext_vector_type(16)));
__device__ __forceinline__ void phase_attn_mfma(const Frame& F, int l) {
    const Args a = load_args(F.lds);
    const bf16* P = (const bf16*)(a.ws + WS_P); bf16* ATT = (bf16*)(a.ws + WS_ATT);
    LAS unsigned char* wl = F.lds + F.wave * 18432;
    LAS unsigned char* Kl = wl; LAS unsigned char* Vl = wl + 4096; LAS float* rb = (LAS float*)(wl + 8192); LAS unsigned char* Ql = wl + 10240;
    const int h = F.wave, lane = F.lane, q31 = lane & 31, hh = lane >> 5;
    constexpr float LOG2E = 1.4426950408889634f;
    __syncthreads();
    { const float* rp = a.rpb + (size_t)(l * 8 + h) * 465; for (int i = lane; i < 465; i += 64) rb[i] = rp[i] * LOG2E; }
    LDS_WAIT();
    const int lkey = lane >> 3, lch = lane & 7;
    const int tq = (lane & 15) >> 2, tp = lane & 3, gI = (lane >> 4) & 1;
    const int nItems = 256 + (l == 0 ? 16 : 0);
    for (int it = F.bid; it < nItems; it += F.G) {
        int b, r, qrow0, rs, ntile;
        if (it < 256) { b = it >> 6; r = it & 63; qrow0 = b * 4096 + r * 64; rs = r - 4; rs = rs < 0 ? 0 : (rs > 56 ? 56 : rs); ntile = 24; }
        else { const int j = it - 256; b = j >> 2; r = 0; rs = 0; qrow0 = ML + b * 256 + (j & 3) * 64; ntile = 8; }
#pragma unroll
        for (int i = 0; i < 8; ++i) { const int qq = lkey + 8 * i;
            const v4u w = *(const v4u*)(P + (size_t)(qrow0 + qq) * INW + COL_Q + h * 64 + lch * 8);
            const float c = 0.125f * LOG2E;
            v4u o; o.x = pk2(pg8::bf_lo(w.x) * c, pg8::bf_hi(w.x) * c); o.y = pk2(pg8::bf_lo(w.y) * c, pg8::bf_hi(w.y) * c);
            o.z = pk2(pg8::bf_lo(w.z) * c, pg8::bf_hi(w.z) * c); o.w = pk2(pg8::bf_lo(w.w) * c, pg8::bf_hi(w.w) * c);
            *(LAS v4u*)(Ql + qq * 128 + ((lch ^ (qq & 7)) << 4)) = o; }
        f32x16 o[2][2];
#pragma unroll
        for (int qb = 0; qb < 2; ++qb)
#pragma unroll
            for (int dt = 0; dt < 2; ++dt)
#pragma unroll
                for (int e = 0; e < 16; ++e) o[qb][dt][e] = 0.f;
        float mrun[2] = {-INFINITY, -INFINITY}, lrun[2] = {0.f, 0.f};
        v4u kr[4], vr[4];
        {   const size_t row0 = (size_t)ML + b * 256;
#pragma unroll
            for (int i = 0; i < 4; ++i) { const bf16* src = P + (row0 + lkey + 8 * i) * INW + h * 64 + lch * 8; kr[i] = *(const v4u*)(src + COL_K); vr[i] = *(const v4u*)(src + COL_V); } }
#pragma unroll 1
        for (int t = 0; t < ntile; ++t) {
#pragma unroll
            for (int i = 0; i < 4; ++i) { const int key = lkey + 8 * i; const int off = key * 128 + ((lch ^ (key & 7)) << 4); *(LAS v4u*)(Kl + off) = kr[i]; *(LAS v4u*)(Vl + off) = vr[i]; }
            if (t + 1 < ntile) { const int tn = t + 1;
                const size_t row0 = (tn < 8) ? (size_t)ML + b * 256 + 32 * tn : (size_t)b * 4096 + (rs + ((tn - 8) >> 1)) * 64 + 32 * ((tn - 8) & 1);
#pragma unroll
                for (int i = 0; i < 4; ++i) { const bf16* src = P + (row0 + lkey + 8 * i) * INW + h * 64 + lch * 8; kr[i] = *(const v4u*)(src + COL_K); vr[i] = *(const v4u*)(src + COL_V); } }
            pg8::bf16x8 kf[4];
#pragma unroll
            for (int ks = 0; ks < 4; ++ks) kf[ks] = *(const LAS pg8::bf16x8*)(Kl + q31 * 128 + (((2 * ks + hh) ^ (q31 & 7)) << 4));
            pg8::bf16x8 vf[2][2];
#pragma unroll
            for (int dt = 0; dt < 2; ++dt)
#pragma unroll
                for (int s2 = 0; s2 < 2; ++s2) {
                    v4i16_t part[2];
#pragma unroll
                    for (int sec = 0; sec < 2; ++sec) { const int key = 16 * s2 + 8 * sec + 4 * hh + tq; const int ch = 4 * dt + 2 * gI + (tp >> 1);
                        part[sec] = __builtin_amdgcn_ds_read_tr16_b64_v4i16((LAS v4i16_t*)(Vl + key * 128 + ((ch ^ (key & 7)) << 4) + 8 * (tp & 1))); }
                    vf[dt][s2] = (pg8::bf16x8){part[0][0], part[0][1], part[0][2], part[0][3], part[1][0], part[1][1], part[1][2], part[1][3]}; }
            const bool local = t >= 8;
            const int ti = (t - 8) >> 1, tc = (t - 8) & 1, dr = rs + ti - r + 7;
#pragma unroll
            for (int qb = 0; qb < 2; ++qb) {
                f32x16 sa;
#pragma unroll
                for (int e = 0; e < 16; ++e) sa[e] = 0.f;
#pragma unroll
                for (int ks = 0; ks < 4; ++ks) { const pg8::bf16x8 qfr = *(const LAS pg8::bf16x8*)(Ql + (32 * qb + q31) * 128 + (((2 * ks + hh) ^ (q31 & 7)) << 4));
                    sa = __builtin_amdgcn_mfma_f32_32x32x16_bf16(kf[ks], qfr, sa, 0, 0, 0); }
                if (local) {
                    const int qc = 32 * qb + q31; int cs = qc - 8; cs = cs < 0 ? 0 : (cs > 48 ? 48 : cs);
#pragma unroll
                    for (int e = 0; e < 16; ++e) { const int kc = 32 * tc + (e & 3) + 8 * (e >> 2) + 4 * hh; int dc = kc - qc + 15; dc = dc < 0 ? 0 : (dc > 30 ? 30 : dc);
                        const float bias = rb[dr * 31 + dc];
                        sa[e] = ((unsigned)(kc - cs) < 16u) ? sa[e] + bias : -INFINITY; }
                }
                float mx = sa[0];
#pragma unroll
                for (int e = 1; e < 16; ++e) mx = fmaxf(mx, sa[e]);
                mx = fmaxf(mx, __shfl_xor(mx, 32));
                const float mnew = fmaxf(mrun[qb], mx);
                const float alpha = __builtin_amdgcn_exp2f(mrun[qb] - mnew);
                mrun[qb] = mnew;
                float ps = 0.f;
#pragma unroll
                for (int e = 0; e < 16; ++e) { sa[e] = __builtin_amdgcn_exp2f(sa[e] - mnew); ps += sa[e]; }
                lrun[qb] = lrun[qb] * alpha + ps;
#pragma unroll
                for (int dt = 0; dt < 2; ++dt)
#pragma unroll
                    for (int e = 0; e < 16; ++e) o[qb][dt][e] *= alpha;
                v4u p0, p1;
                p0.x = pg8::cvt_pk_bf16(sa[0], sa[1]); p0.y = pg8::cvt_pk_bf16(sa[2], sa[3]); p0.z = pg8::cvt_pk_bf16(sa[4], sa[5]); p0.w = pg8::cvt_pk_bf16(sa[6], sa[7]);
                p1.x = pg8::cvt_pk_bf16(sa[8], sa[9]); p1.y = pg8::cvt_pk_bf16(sa[10], sa[11]); p1.z = pg8::cvt_pk_bf16(sa[12], sa[13]); p1.w = pg8::cvt_pk_bf16(sa[14], sa[15]);
                const pg8::bf16x8 pb0 = __builtin_bit_cast(pg8::bf16x8, p0), pb1 = __builtin_bit_cast(pg8::bf16x8, p1);
#pragma unroll
                for (int dt = 0; dt < 2; ++dt) {
                    o[qb][dt] = __builtin_amdgcn_mfma_f32_32x32x16_bf16(vf[dt][0], pb0, o[qb][dt], 0, 0, 0);
                    o[qb][dt] = __builtin_amdgcn_mfma_f32_32x32x16_bf16(vf[dt][1], pb1, o[qb][dt], 0, 0, 0); }
            }
        }
#pragma unroll
        for (int qb = 0; qb < 2; ++qb) {
            const float lt = lrun[qb] + __shfl_xor(lrun[qb], 32);
            const float inv = 1.0f / lt;
            bf16* orow = ATT + (size_t)(qrow0 + 32 * qb + q31) * 512 + h * 64 + 4 * hh;
#pragma unroll
            for (int dt = 0; dt < 2; ++dt)
#pragma unroll
                for (int g4 = 0; g4 < 4; ++g4) {
                    const v2u w = (v2u){pg8::cvt_pk_bf16(o[qb][dt][4 * g4] * inv, o[qb][dt][4 * g4 + 1] * inv), pg8::cvt_pk_bf16(o[qb][dt][4 * g4 + 2] * inv, o[qb][dt][4 * g4 + 3] * inv)};
                    *(v2u*)(orow + 32 * dt + 8 * g4) = w; }
        }
    }
    __syncthreads();
}

__device__ __forceinline__ void phase_fourier_simple(const Frame& F, int l) {
    const Args a = load_args(F.lds);
    const bf16* P = (const bf16*)(a.ws + WS_P); bf16* FY = (bf16*)(a.ws + WS_FY);
    const float2* tw = (const float2*)(a.ws + WS_TW);
    LAS float* X = (LAS float*)(F.lds);
    LAS f32x2* Z = (LAS f32x2*)(F.lds + 32768);
    LAS float* c64 = (LAS float*)(F.lds + 32768 + 66048); LAS float* s64 = c64 + 64;
    LAS float* c256 = s64 + 64; LAS float* s256 = c256 + 256;
    __syncthreads();
    if (F.tid < 64) { float sv, cv; sincosf((float)F.tid * 0.09817477042468103f, &sv, &cv); c64[F.tid] = cv; s64[F.tid] = sv; }
    if (F.tid < 256) { float sv, cv; sincosf((float)F.tid * 0.02454369260617026f, &sv, &cv); c256[F.tid] = cv; s256[F.tid] = sv; }
    __syncthreads();
    const int g = F.tid >> 7, lo = F.tid & 127;
    for (int it = F.bid; it < 512; it += F.G) {
        const int b = it >> 7, c0 = (it & 127) * 2;
        __syncthreads();
        for (int t = F.tid; t < 4096; t += NT) { const unsigned w = *(const unsigned*)(P + (size_t)(b * 4096 + t) * INW + COL_F + c0); X[2 * t] = pg8::bf_lo(w); X[2 * t + 1] = pg8::bf_hi(w); }
        __syncthreads();
        {
            float ar[16], ai[16];
#pragma unroll
            for (int k = 0; k < 16; ++k) { ar[k] = 0.f; ai[k] = 0.f; }
            for (int t1 = 0; t1 < 64; ++t1) { const float x = X[t1 * 128 + lo];
#pragma unroll
                for (int k = 0; k < 16; ++k) { const int idx = ((g * 16 + k) * t1) & 63; ar[k] += x * c64[idx]; ai[k] -= x * s64[idx]; } }
            const int t2 = lo >> 1;
#pragma unroll
            for (int k = 0; k < 16; ++k) { const int k1 = g * 16 + k; const float2 w = tw[t2 * k1];
                Z[k1 * 129 + lo] = (f32x2){ar[k] * w.x + ai[k] * w.y, ai[k] * w.x - ar[k] * w.y}; }
        }
        __syncthreads();
        {
            float yr[16], yi[16];
#pragma unroll
            for (int k = 0; k < 16; ++k) { yr[k] = 0.f; yi[k] = 0.f; }
            const int k1 = lo >> 1, c = lo & 1;
            for (int t2 = 0; t2 < 64; ++t2) { const f32x2 z = Z[k1 * 129 + t2 * 2 + c];
#pragma unroll
                for (int k = 0; k < 16; ++k) { const int idx = ((g * 16 + k) * t2) & 63; const float cv = c64[idx], sv = s64[idx]; yr[k] += z.x * cv + z.y * sv; yi[k] += z.y * cv - z.x * sv; } }
#pragma unroll
            for (int k = 0; k < 16; ++k) { const int k2 = g * 16 + k; bf16* o = FY + (size_t)(b * 4096 + k1 + 64 * k2) * 512 + c0 + c;
                o[0] = (bf16)f2bf(yr[k] * (1.0f / 64.0f)); o[256] = (bf16)f2bf(yi[k] * (1.0f / 64.0f)); }
        }
    }
    if (l == 0) {
        for (int it = F.bid; it < 512; it += F.G) {
            const int b = it >> 7, c0 = (it & 127) * 2;
            __syncthreads();
            if (F.tid < 256) { const unsigned w = *(const unsigned*)(P + (size_t)(ML + b * 256 + F.tid) * INW + COL_F + c0); X[2 * F.tid] = pg8::bf_lo(w); X[2 * F.tid + 1] = pg8::bf_hi(w); }
            __syncthreads();
            const int k = F.tid >> 1, c = F.tid & 1; float yr = 0.f, yi = 0.f;
            for (int t = 0; t < 256; ++t) { const float x = X[2 * t + c]; const int idx = (k * t) & 255; yr += x * c256[idx]; yi -= x * s256[idx]; }
            bf16* o = FY + (size_t)(ML + b * 256 + k) * 512 + c0 + c;
            o[0] = (bf16)f2bf(yr * (1.0f / 16.0f)); o[256] = (bf16)f2bf(yi * (1.0f / 16.0f));
        }
    }
    __syncthreads();
}

__device__ __forceinline__ void phase_route(const Frame& F, int l) {
    const Args a = load_args(F.lds);
    const float* mod = (const float*)(a.ws + WS_MOD) + (size_t)l * 5 * 6144; bf16* H = (bf16*)(a.ws + WS_H);
    const float* ctxn = (const float*)(a.ws + WS_CTXN);
    int* route = (int*)(a.ws + WS_ROUTE);
    unsigned* cnt = (unsigned*)(a.ws + WS_CTL) + CW_CNT + l * 16;
    const int rows = (l == 0) ? MA : ML;
    LAS float* rwT = (LAS float*)F.lds;
    __syncthreads();
    for (int i = F.tid; i < 4096; i += NT) { const f32x4 w = *(const f32x4*)(a.router_w + (size_t)i * 4); const int k = i >> 2, e0 = (i & 3) * 4;
        rwT[(e0 + 0) * 1024 + k] = w.x; rwT[(e0 + 1) * 1024 + k] = w.y; rwT[(e0 + 2) * 1024 + k] = w.z; rwT[(e0 + 3) * 1024 + k] = w.w; }
    __syncthreads();
    for (int r = F.gw; r < rows; r += F.NGW) {
        const float* src = (r < ML) ? a.out + (size_t)r * D : ctxn + (size_t)(r - ML) * D;
        const int j = (r < ML) ? (r >> 12) : 4;
        f32x4 v[4];
#pragma unroll
        for (int q = 0; q < 4; ++q) v[q] = *(const f32x4*)(src + 4 * F.lane + 256 * q);
        const float* m = mod + (size_t)j * 6144;
        norm_mod_store(v, a.norm2_g + l * 1024, m + 3072, m + 4096, H + (size_t)r * D, F.lane);
        float lg[16];
#pragma unroll
        for (int e = 0; e < 16; ++e) { float t = 0.f;
#pragma unroll
            for (int q = 0; q < 4; ++q) { const f32x4 w = *(const LAS f32x4*)(rwT + e * 1024 + 256 * q + 4 * F.lane); t += (v[q].x * w.x + v[q].y * w.y) + (v[q].z * w.z + v[q].w * w.w); }
            lg[e] = t; }
#pragma unroll
        for (int e = 0; e < 16; ++e) lg[e] = wave_sum(lg[e]);
        float s[16], sb[16];
#pragma unroll
        for (int e = 0; e < 16; ++e) { s[e] = 1.0f / (1.0f + expf(-lg[e])); sb[e] = s[e] + a.router_b[e]; }
        int bg = 0; float bgs = -1e30f;
#pragma unroll
        for (int g = 0; g < 4; ++g) { float m1 = -1e30f, m2 = -1e30f;
#pragma unroll
            for (int k = 0; k < 4; ++k) { const float x = sb[4 * g + k]; if (x > m1) { m2 = m1; m1 = x; } else if (x > m2) m2 = x; }
            const float gs = m1 + m2; if (gs > bgs) { bgs = gs; bg = g; } }
        float gsb[4], gs_[4];
#pragma unroll
        for (int k = 0; k < 4; ++k) { gsb[k] = bg == 0 ? sb[k] : (bg == 1 ? sb[4 + k] : (bg == 2 ? sb[8 + k] : sb[12 + k])); gs_[k] = bg == 0 ? s[k] : (bg == 1 ? s[4 + k] : (bg == 2 ? s[8 + k] : s[12 + k])); }
        int i1 = 0; float b1 = gsb[0], s1 = gs_[0];
#pragma unroll
        for (int k = 1; k < 4; ++k) if (gsb[k] > b1) { b1 = gsb[k]; i1 = k; s1 = gs_[k]; }
        int i2 = -1; float b2 = -1e30f, s2 = 0.f;
#pragma unroll
        for (int k = 0; k < 4; ++k) if (k != i1 && gsb[k] > b2) { b2 = gsb[k]; i2 = k; s2 = gs_[k]; }
        if (F.lane == 0) {
            const int e0 = bg * 4 + i1, e1 = bg * 4 + i2;
            const unsigned p0 = __hip_atomic_fetch_add(cnt + e0, 1u, __ATOMIC_RELAXED, __HIP_MEMORY_SCOPE_AGENT);
            const unsigned p1 = __hip_atomic_fetch_add(cnt + e1, 1u, __ATOMIC_RELAXED, __HIP_MEMORY_SCOPE_AGENT);
            const float inv = 1.0f / (s1 + s2);
            int* rr = route + (size_t)r * 8; rr[0] = e0; rr[1] = e1; rr[2] = (int)p0; rr[3] = (int)p1; rr[4] = __builtin_bit_cast(int, s1 * inv); rr[5] = __builtin_bit_cast(int, s2 * inv);
        }
    }
}

__device__ __forceinline__ int expert_prefix(const Frame& F, int l, LAS int* ps) {
    const Args a = load_args(F.lds);
    const unsigned* cnt = (const unsigned*)(a.ws + WS_CTL) + CW_CNT + l * 16;
    __syncthreads();
    if (F.tid == 0) { int acc = 0; for (int e = 0; e < 16; ++e) { ps[e] = acc; const int c = (int)__hip_atomic_load(cnt + e, __ATOMIC_RELAXED, __HIP_MEMORY_SCOPE_AGENT); acc += ((c + 255) >> 8) << 8; } ps[16] = acc; }
    __syncthreads();
    return ps[16] >> 8;
}

__device__ __forceinline__ void phase_gather(const Frame& F, int l) {
    const Args a = load_args(F.lds);
    const bf16* H = (const bf16*)(a.ws + WS_H); bf16* XG = (bf16*)(a.ws + WS_XG);
    int* route = (int*)(a.ws + WS_ROUTE);
    LAS int* ps = (LAS int*)(F.lds + LDS_TILE_E);
    (void)expert_prefix(F, l, ps);
    const int rows = (l == 0) ? MA : ML;
    for (int r = F.gw; r < rows; r += F.NGW) {
        int* rr = route + (size_t)r * 8;
        const int e0 = rr[0], e1 = rr[1], p0 = rr[2], p1 = rr[3];
        const int d0 = ps[e0] + p0, d1 = ps[e1] + p1;
        const v4u* src = (const v4u*)(H + (size_t)r * D);
        const v4u x0 = src[F.lane], x1 = src[64 + F.lane];
        v4u* o0 = (v4u*)(XG + (size_t)d0 * D); v4u* o1 = (v4u*)(XG + (size_t)d1 * D);
        o0[F.lane] = x0; o0[64 + F.lane] = x1; o1[F.lane] = x0; o1[64 + F.lane] = x1;
        if (F.lane == 0) { rr[6] = d0; rr[7] = d1; }
    }
}

__device__ __forceinline__ int moe_tiles(const Frame& F, int l) {
    LAS int* ps = (LAS int*)(F.lds + LDS_TILE_E); LAS int* te = ps + 32;
    const int T = expert_prefix(F, l, ps);
    for (int t = F.tid; t < T; t += NT) { int e = 0;
#pragma unroll
        for (int q = 1; q < 16; ++q) if ((ps[q] >> 8) <= t) e = q;
        te[t] = e; }
    __syncthreads();
    return T;
}

__device__ __forceinline__ void phase_combine(const Frame& F, int l) {
    const Args a = load_args(F.lds);
    const float* mod = (const float*)(a.ws + WS_MOD) + (size_t)l * 5 * 6144; bf16* H = (bf16*)(a.ws + WS_H);
    const float* ctxn = (const float*)(a.ws + WS_CTXN); const bf16* Y = (const bf16*)(a.ws + WS_Y);
    const int* route = (const int*)(a.ws + WS_ROUTE);
    const int rows = (l == 0) ? MA : ML;
    for (int r = F.gw; r < rows; r += F.NGW) {
        const bool lat = r < ML;
        const float* src = lat ? a.out + (size_t)r * D : ctxn + (size_t)(r - ML) * D;
        const int j = lat ? (r >> 12) : 4;
        const int* rr = route + (size_t)r * 8;
        const float w0 = __builtin_bit_cast(float, rr[4]), w1 = __builtin_bit_cast(float, rr[5]);
        const bf16* y0 = Y + (size_t)rr[6] * D; const bf16* y1 = Y + (size_t)rr[7] * D;
        const float* g2 = mod + (size_t)j * 6144 + 5120;
        f32x4 v[4];
#pragma unroll
        for (int q = 0; q < 4; ++q) { const int k = 4 * F.lane + 256 * q;
            const f32x4 xv = *(const f32x4*)(src + k), gg = *(const f32x4*)(g2 + k);
            const v2u a0 = *(const v2u*)(y0 + k), a1 = *(const v2u*)(y1 + k);
            f32x4 yy;
            yy.x = w0 * pg8::bf_lo(a0.x) + w1 * pg8::bf_lo(a1.x); yy.y = w0 * pg8::bf_hi(a0.x) + w1 * pg8::bf_hi(a1.x);
            yy.z = w0 * pg8::bf_lo(a0.y) + w1 * pg8::bf_lo(a1.y); yy.w = w0 * pg8::bf_hi(a0.y) + w1 * pg8::bf_hi(a1.y);
            v[q] = xv + gg * yy;
            if (lat) *(f32x4*)(a.out + (size_t)r * D + k) = v[q]; }
        if (l == 0) { const float* m1 = (const float*)(a.ws + WS_MOD) + (size_t)(5 + j) * 6144;
            norm_mod_store(v, a.norm1_g + 1024, m1, m1 + 1024, H + (size_t)r * D, F.lane); }
    }
}

#define XB_TMO      128
#define XB_XCNT(j)  (256  + 64 * (j))
#define XB_XSUB(j)  (1280 + 64 * (j))
#define XB_XGEN(j)  (2304 + 64 * (j))
#define XB_TOP      3328
#define XB_TOPGEN   3392
#define XCD_BAR_WORDS 3456
#define XB_SPIN_CAP (1u << 18)
__device__ __forceinline__ unsigned xb_ld(unsigned* p)              { return __hip_atomic_load(p, __ATOMIC_RELAXED, __HIP_MEMORY_SCOPE_AGENT); }
__device__ __forceinline__ unsigned xb_add(unsigned* p, unsigned v) { return __hip_atomic_fetch_add(p, v, __ATOMIC_RELAXED, __HIP_MEMORY_SCOPE_AGENT); }
__device__ __forceinline__ unsigned xb_xcc_id() { return (unsigned)__builtin_amdgcn_s_getreg((3 << 11) | 20) & 0xFu; }
#define XB_SPIN(cond, bar) do { unsigned _sp = 0; while (cond) { __builtin_amdgcn_s_sleep(1); \
    if ((++_sp & 255u) == 0u) { if (xb_ld(&(bar)[XB_TMO])) break; if (_sp > XB_SPIN_CAP) { atomicAdd(&(bar)[XB_TMO], 1u); break; } } } } while (0)
struct XcdBarrier { unsigned* bar; unsigned x; volatile LAS unsigned* st; };
__device__ __forceinline__ XcdBarrier xcd_barrier_post(unsigned* bar, volatile LAS unsigned* st) {
    XcdBarrier b; b.bar = bar; b.x = xb_xcc_id(); b.st = st;
    if (threadIdx.x == 0) (void)xb_add(&bar[XB_XCNT(b.x)], 1u);
    return b;
}
__device__ __forceinline__ void xcd_barrier_complete(unsigned* bar, unsigned x, unsigned& nloc, unsigned& nx) {
    const unsigned G = gridDim.x * gridDim.y * gridDim.z;
    unsigned sum, cnt, mine, sp = 0u;
    for (;;) {
        sum = 0u; cnt = 0u; mine = 0u;
#pragma unroll
        for (unsigned j = 0; j < 16; ++j) { const unsigned c = xb_ld(&bar[XB_XCNT(j)]); sum += c; cnt += (c > 0u) ? 1u : 0u; mine = (j == x) ? c : mine; }
        if (sum == G) break;
        __builtin_amdgcn_s_sleep(1);
        if ((++sp & 255u) == 0u) { if (xb_ld(&bar[XB_TMO])) break; if (sp > XB_SPIN_CAP) { atomicAdd(&bar[XB_TMO], 1u); break; } }
    }
    nloc = mine > 0u ? mine : 1u; nx = cnt > 0u ? cnt : 1u;
}
__device__ __forceinline__ void xcd_barrier(const XcdBarrier& b) {
    asm volatile("s_waitcnt vmcnt(0)" ::: "memory");
    __syncthreads();
    if (threadIdx.x == 0) {
        unsigned* bar = b.bar;
        __builtin_amdgcn_s_waitcnt(0);
        unsigned nloc = b.st[0], nx = b.st[1];
        if (nloc == 0u) { xcd_barrier_complete(bar, b.x, nloc, nx); b.st[0] = nloc; b.st[1] = nx; }
        const unsigned old = xb_add(&bar[XB_XSUB(b.x)], 1u);
        const unsigned gen = old / nloc;
        if (old + 1u == (gen + 1u) * nloc) {
            __builtin_amdgcn_fence(__ATOMIC_RELEASE, "agent");
            asm volatile("s_waitcnt vmcnt(0)" ::: "memory");
            const unsigned og = xb_add(&bar[XB_TOP], 1u);
            const unsigned tg = og / nx;
            if (og + 1u == (tg + 1u) * nx) xb_add(&bar[XB_TOPGEN], 1u);
            else XB_SPIN(xb_ld(&bar[XB_TOPGEN]) == tg, bar);
            __builtin_amdgcn_fence(__ATOMIC_ACQUIRE, "agent");
            xb_add(&bar[XB_XGEN(b.x)], 1u);
            asm volatile("s_waitcnt vmcnt(0)" ::: "memory");
        } else {
            XB_SPIN(xb_ld(&bar[XB_XGEN(b.x)]) == gen, bar);
            __builtin_amdgcn_fence(__ATOMIC_ACQUIRE, "agent");
            asm volatile("s_waitcnt vmcnt(0)" ::: "memory");
        }
    }
    __syncthreads();
}

namespace pg8 {
enum { EM_PLAIN = 0, EM_IN = 1, EM_MERGE = 2, EM_OUT = 3, EM_MOE1 = 4 };
struct EpiAll {
    static constexpr bool PERM = true, AFTER_DRAIN = false;
    int mode, l, sub; LAS unsigned char* lds;
    __device__ __forceinline__ void operator()(const f32x4 (&acc)[2][2][4][2], const Unit& u, int wr, int wc, int fr, int fq) const {
        asm volatile("" : "+v"(fr), "+v"(fq));
        unsigned char* ws = (unsigned char*)ldp(lds, 23);
        bf16* Hb = (bf16*)(ws + WS_H); bf16* Pb = (bf16*)(ws + WS_P);
        switch (mode) {
            case EM_PLAIN: { const EpiPlain e{(bf16*)(ws + WS_Y), D}; e(acc, u, wr, wc, fr, fq); } break;
            case EM_IN:    { const EpiIn e{Pb, INW, (const float*)ldp(lds, 8) + l * 64, (const float*)ldp(lds, 9) + l * 64, (const float2*)(ws + WS_ROPE), 64}; e(acc, u, wr, wc, fr, fq); } break;
            case EM_MERGE: { const EpiMerge e{Hb, Pb, INW, COL_G + sub * 1024, sub != 0 ? 1 : 0}; e(acc, u, wr, wc, fr, fq); } break;
            case EM_OUT:   { float* out = (float*)ldp(lds, 22); const float* mod = (const float*)(ws + WS_MOD) + (size_t)l * 5 * 6144;
                             const EpiOut e{l == 0 ? (const float*)ldp(lds, 0) : (const float*)out, out, (const float*)ldp(lds, 2), (float*)(ws + WS_CTXN), mod + 2048}; e(acc, u, wr, wc, fr, fq); } break;
            default:       { const EpiMoe1 e{(bf16*)(ws + WS_ACT)}; e(acc, u, wr, wc, fr, fq); } break;
        }
    }
};
}

constexpr int N_PHASES = 2 + 9 * DEPTH;
#ifndef ATTN_SIMPLE
#define ATTN_SIMPLE 0
#endif
#ifndef REP_MASK
#define REP_MASK 0
#endif
__global__ void __launch_bounds__(NT, 2) mk_fwd(Args a) {
    extern __shared__ __attribute__((aligned(16))) unsigned char lds_raw[];
    LAS unsigned char* const lds0 = (LAS unsigned char*)lds_raw;
    volatile LAS unsigned* MISC = (volatile LAS unsigned*)(lds0 + LDS_MISC);
    if (threadIdx.x < 64) MISC[threadIdx.x] = 0u;
    if (threadIdx.x < 24) { const unsigned long long* ap = (const unsigned long long*)&a; ((LAS unsigned long long*)(lds0 + LDS_ATAB))[threadIdx.x] = ap[threadIdx.x]; }
    const int lo = a.ph_lo, hi = a.ph_hi;
    unsigned* barw = (unsigned*)(a.ws + WS_CTL) + CW_BAR;
    __syncthreads();
    XcdBarrier bar; bar.bar = barw; bar.x = 0; bar.st = nullptr;
    if (hi - lo > 1) bar = xcd_barrier_post(barw, MISC + 8);
    int ph = lo, sub = 0, rep_done = 0;
#pragma unroll 1
    while (ph < hi) {
        int tid_o = threadIdx.x, bid_o = blockIdx.x, grid_o = gridDim.x;
        asm volatile("" : "+v"(tid_o)); asm volatile("" : "+s"(bid_o), "+s"(grid_o));
        Frame F;
        F.lds = lds0;
        F.tid = tid_o; F.lane = F.tid & 63; F.wave = __builtin_amdgcn_readfirstlane(F.tid >> 6);
        F.G = grid_o; F.bid = bid_o; F.gw = bid_o * NWAVES + F.wave; F.NGW = F.G * NWAVES;
        const int l = ph < 2 ? 0 : (ph - 2) / 9, k = ph < 2 ? -1 : (ph - 2) % 9;
        unsigned char* ws = (unsigned char*)ldp(F.lds, 23);
        bool isg = false; int nsub = 1;
        pg8::Gemm g{nullptr, nullptr, 0, 0, 0}; pg8::Order S; S.init(1, 1, F.G, F.bid); pg8::EpiAll E{0, l, sub, F.lds};
        if (ph == 0) { for (int rp = 0; rp < 1 + ((REP_MASK >> 14) & 1); ++rp) phase_prologue(F); }
        else if (ph == 1) { for (int rp = 0; rp < 1 + ((REP_MASK >> 17) & 1); ++rp) phase_norm_a0(F); }
        else if (k == 0) {
            isg = true; g.A = (const bf16*)(ws + WS_H); g.Bt = (const bf16*)(ws + WS_WIN); g.K = D;
            S.init(l == 0 ? 68 : 64, 22, F.G, F.bid);
            if (l != 0) { S.exM0 = 64; S.exN = 4; S.exPn0 = 3; S.nExtra = 16; }
            E.mode = pg8::EM_IN;
        } else if (k == 1) {
            for (int rp = 0; rp < 1 + ((REP_MASK >> 15) & 1); ++rp) phase_conv(F, l);
            for (int rp = 0; rp < 1 + ((REP_MASK >> 12) & 1); ++rp) phase_fourier_simple(F, l);
            for (int rp = 0; rp < 1 + ((REP_MASK >> 13) & 1); ++rp) {
#if ATTN_SIMPLE
                phase_attn_simple(F, l);
#else
                phase_attn_mfma(F, l);
#endif
            } }
        else if (k == 2) {
            isg = true; nsub = 3; S.init(l == 0 ? 68 : 64, 4, F.G, F.bid);
            E.mode = pg8::EM_MERGE;
            if (sub == 0) { g.A = (const bf16*)(ws + WS_FY); g.Bt = (const bf16*)(ws + WS_WF); g.K = 512; }
            else if (sub == 1) { g.A = (const bf16*)(ws + WS_ATT); g.Bt = (const bf16*)(ws + WS_WNA); g.K = 512; }
            else { g.A = (const bf16*)(ws + WS_YCV); g.Bt = (const bf16*)(ws + WS_WCV); g.K = 256; }
        } else if (k == 3) {
            isg = true; S.init(l == 0 ? 68 : 64, 4, F.G, F.bid);
            g.A = (const bf16*)(ws + WS_H); g.Bt = (const bf16*)(ws + WS_WO); g.K = D;
            E.mode = pg8::EM_OUT;
        } else if (k == 4) phase_route(F, l);
        else if (k == 5) { for (int rp = 0; rp < 1 + ((REP_MASK >> 16) & 1); ++rp) phase_gather(F, l); }
        else if (k == 6 || k == 7) {
            isg = true; const int T = moe_tiles(F, l);
            S.moeUnits = T * 4; S.tile_e = (const LAS int*)(F.lds + LDS_TILE_E) + 32;
            if (k == 6) { g.A = (const bf16*)(ws + WS_XG); g.Bt = (const bf16*)(ws + WS_W13); g.K = D; E.mode = pg8::EM_MOE1; }
            else { g.A = (const bf16*)(ws + WS_ACT); g.Bt = (const bf16*)(ws + WS_W2); g.K = DE; E.mode = pg8::EM_PLAIN; }
        } else { phase_combine(F, l); if (l + 1 < DEPTH) { for (int rp = 0; rp < 1 + ((REP_MASK >> 18) & 1); ++rp) convert_weights(F, l + 1); } }
        if (isg) { const int nrep = (k >= 0 && ((REP_MASK >> k) & 1)) ? 2 : 1;
#pragma unroll 1
            for (int rp = 0; rp < nrep; ++rp) pg8::gemm_phase<pg8::EpiAll, pg8::Order, true, true>(F.lds, g, S, E); }
        if (sub + 1 < nsub) { ++sub; continue; }
        if (k >= 0 && ((REP_MASK >> (20 + k)) & 1) && !(k == 3 && l != 0) && rep_done == 0) { rep_done = 1; sub = 0; continue; }
        rep_done = 0; sub = 0; ++ph;
        if (ph < hi) xcd_barrier(bar);
    }
}

#ifndef MK_SINGLE
#define MK_SINGLE 1
#endif
extern "C" void kernel_launch(void* const* d_in, const int* in_sizes, int n_in, void* d_out, int out_size, void* d_ws, size_t ws_size, hipStream_t stream) {
    static int grid = 0;
    if (grid == 0) {
        if (n_in != 22 || out_size != ML * D || ws_size < WS_END) { fprintf(stderr, "kernel_launch: unexpected shapes (n_in %d out %d ws %zu need %zu)\n", n_in, out_size, ws_size, (size_t)WS_END); grid = -1; return; }
        int dev = 0, cus = 0;
        if (hipGetDevice(&dev) != hipSuccess || hipDeviceGetAttribute(&cus, hipDeviceAttributeMultiprocessorCount, dev) != hipSuccess) { grid = -1; return; }
        if (hipFuncSetAttribute((const void*)mk_fwd, hipFuncAttributeMaxDynamicSharedMemorySize, LDS_BYTES) != hipSuccess) { fprintf(stderr, "kernel_launch: hipFuncSetAttribute failed\n"); grid = -1; return; }
        int per_cu = 0;
        if (hipOccupancyMaxActiveBlocksPerMultiprocessor(&per_cu, (const void*)mk_fwd, NT, LDS_BYTES) != hipSuccess || per_cu < 1) fprintf(stderr, "kernel_launch: occupancy query says %d\n", per_cu);
        (void)hipGetLastError();
        grid = cus;
    }
    if (grid < 0) return;
    (void)hipMemsetAsync((char*)d_ws + WS_CTL, 0, CTL_ZERO_BYTES, stream);
    Args a{};
    const float** ap = (const float**)&a;
    for (int i = 0; i < 22; ++i) ap[i] = (const float*)d_in[i];
    a.out = (float*)d_out; a.ws = (unsigned char*)d_ws;
#if MK_SINGLE
    a.ph_lo = 0; a.ph_hi = N_PHASES;
    hipLaunchKernelGGL(mk_fwd, dim3(grid), dim3(NT), LDS_BYTES, stream, a);
#else
    for (int p = 0; p < N_PHASES; ++p) { a.ph_lo = p; a.ph_hi = p + 1; hipLaunchKernelGGL(mk_fwd, dim3(grid), dim3(NT), LDS_BYTES, stream, a); }
#endif
}
```

```cpp
#include <hip/hip_runtime.h>
#include <cstdio>
#include <cstdint>

namespace pg8 {
#define PG8_LAS __attribute__((address_space(3)))
typedef unsigned short bf16_t;
typedef short bf16x8 __attribute__((ext_vector_type(8)));
typedef float f32x4 __attribute__((ext_vector_type(4)));
typedef unsigned u32x4 __attribute__((ext_vector_type(4)));
typedef unsigned u32x2 __attribute__((ext_vector_type(2)));
constexpr int BM = 256, BK = 64, HALF = 128, HTB = HALF * BK * 2  , STAGE_BYTES = 8 * HTB, NXCD = 8, WGM = 8;

__host__ __device__ __forceinline__ int lds_byte(int r, int c) { const int st = (r >> 4) * 2 + (c >> 5), rr = r & 15, cc = c & 31, ob = rr * 64 + cc * 2; return st * 1024 + (ob ^ (((ob >> 9) & 1) << 5)); }
__host__ __device__ __forceinline__ void stage_rc(int b, int& R, int& C) { const int st = b / 1024, sb = b % 1024, swz = sb ^ (((sb >> 9) & 1) << 5); R = (st >> 1) * 16 + swz / 64; C = (st & 1) * 32 + (swz % 64) / 2; }
__host__ __device__ __forceinline__ int perm32(int rho) { const int n = rho >> 4, i = rho & 15; return 8 * (i >> 2) + 4 * n + (i & 3); }

struct Unit { int pm, pn, pb; };
struct Gemm { const bf16_t* A; const bf16_t* Bt; int M, N, K; };

struct Order {
    int nM, nN, nwg, G, c, exM0, exN, exPn0, nExtra, moeUnits; const PG8_LAS int* tile_e;
    __device__ void init(int nM_, int nN_, int G_, int c_) { nM = nM_; nN = nN_; nwg = nM * nN; G = G_; c = c_; exM0 = 0; exN = 1; exPn0 = 0; nExtra = 0; moeUnits = -1; tile_e = nullptr; }
    __device__ bool next(int i, Unit& u) const {
        const long L = (long)i * G + c;
        if (moeUnits >= 0) { if (L >= moeUnits) return false; const int t = (int)L >> 2; u.pm = t; u.pn = (int)L & 3; u.pb = tile_e[t] * 4 + u.pn; return true; }
        if (L >= nwg) { const int x = (int)(L - nwg); if (x >= nExtra) return false; u.pm = exM0 + x / exN; u.pn = exPn0 + x % exN; u.pb = u.pn; return true; }
        int wgid = (int)L; { const int q = nwg / NXCD, r = nwg % NXCD, xcd = wgid % NXCD, off = wgid / NXCD; wgid = (xcd < r ? xcd * (q + 1) : r * (q + 1) + (xcd - r) * q) + off; }
        const int nig = WGM * nN, gid = wgid / nig, fm = gid * WGM, gsz = (nM - fm) < WGM ? (nM - fm) : WGM;
        u.pm = fm + ((wgid % nig) % gsz); u.pn = (wgid % nig) / gsz; u.pb = u.pn; return true;
    }
    __device__ __forceinline__ void a_ready(const Unit&) const {}
    __device__ __forceinline__ void done(const Unit&) const {}
};

__device__ __forceinline__ unsigned cvt_pk_bf16(float lo, float hi) { unsigned r; asm volatile("v_cvt_pk_bf16_f32 %0, %1, %2" : "=v"(r) : "v"(lo), "v"(hi)); return r; }
__device__ __forceinline__ float bf_lo(unsigned w) { return __builtin_bit_cast(float, w << 16); }
__device__ __forceinline__ float bf_hi(unsigned w) { return __builtin_bit_cast(float, w & 0xffff0000u); }
__device__ __forceinline__ float sigmoidf_(float v) { return __builtin_amdgcn_rcpf(1.0f + __expf(-v)); }
__device__ __forceinline__ u32x4 pack8(const f32x4& v0, const f32x4& v1) { u32x4 w; w.x = cvt_pk_bf16(v0[0], v0[1]); w.y = cvt_pk_bf16(v0[2], v0[3]); w.z = cvt_pk_bf16(v1[0], v1[1]); w.w = cvt_pk_bf16(v1[2], v1[3]); return w; }

struct EpiPlain {
    static constexpr bool PERM = true, AFTER_DRAIN = false;
    bf16_t* O; int ldc;
    __device__ __forceinline__ void operator()(const f32x4 (&acc)[2][2][4][2], const Unit& u, int wr, int wc, int fr, int fq) const {
        const int row0 = u.pm * BM + wr * 64 + fr, col0 = u.pn * BM + wc * 32 + 8 * fq;
#pragma unroll
        for (int ai = 0; ai < 2; ++ai)
#pragma unroll
            for (int m = 0; m < 4; ++m) { bf16_t* rowp = O + (size_t)(row0 + ai * HALF + m * 16) * ldc + col0;
#pragma unroll
                for (int bj = 0; bj < 2; ++bj) *(u32x4*)(rowp + bj * HALF) = pack8(acc[ai][bj][m][0], acc[ai][bj][m][1]); }
    }
};

struct EpiIn {
    static constexpr bool PERM = true, AFTER_DRAIN = false;
    bf16_t* P; int ldc; const float* qg; const float* kg; const float2* rope; int latent_tiles;
    __device__ __forceinline__ void operator()(const f32x4 (&acc)[2][2][4][2], const Unit& u, int wr, int wc, int fr, int fq) const {
        const int pn = u.pn;
        const int row0 = u.pm * BM + wr * 64 + fr;
        if (pn >= 1 && pn <= 4) {
            const float* g = (pn <= 2) ? qg : kg;
            f32x4 gv[2][2];
#pragma unroll
            for (int bj = 0; bj < 2; ++bj)
#pragma unroll
                for (int n = 0; n < 2; ++n) gv[bj][n] = *(const f32x4*)(g + 32 * bj + 8 * fq + 4 * n);
            const bool lat = u.pm < latent_tiles;
#pragma unroll
            for (int ai = 0; ai < 2; ++ai)
#pragma unroll
                for (int m = 0; m < 4; ++m) {
                    float ss = 0.f;
#pragma unroll
                    for (int bj = 0; bj < 2; ++bj)
#pragma unroll
                        for (int n = 0; n < 2; ++n) { const f32x4 x = acc[ai][bj][m][n]; ss += (x[0] * x[0] + x[1] * x[1]) + (x[2] * x[2] + x[3] * x[3]); }
                    ss += __shfl_xor(ss, 16); ss += __shfl_xor(ss, 32);
                    const float rstd = __builtin_amdgcn_rsqf(ss * (1.0f / 64.0f) + 1e-6f);
                    f32x4 y[2][2];
#pragma unroll
                    for (int bj = 0; bj < 2; ++bj)
#pragma unroll
                        for (int n = 0; n < 2; ++n) y[bj][n] = acc[ai][bj][m][n] * rstd * gv[bj][n];
                    if (lat) {
                        const int pos = (fq < 2) ? ((4 * u.pm + 2 * ai + wr) & 63) : (16 * m + fr);
                        const float2* cs = rope + pos * 16 + 8 * (fq & 1);
#pragma unroll
                        for (int n = 0; n < 2; ++n)
#pragma unroll
                            for (int i = 0; i < 4; ++i) { const float2 c = cs[4 * n + i]; const float x1 = y[0][n][i], x2 = y[1][n][i]; y[0][n][i] = x1 * c.x - x2 * c.y; y[1][n][i] = x2 * c.x + x1 * c.y; }
                    }
                    bf16_t* rowp = P + (size_t)(row0 + ai * HALF + m * 16) * ldc + pn * BM + 64 * wc + 8 * fq;
#pragma unroll
                    for (int bj = 0; bj < 2; ++bj) *(u32x4*)(rowp + 32 * bj) = pack8(y[bj][0], y[bj][1]);
                }
        } else {
            const bool gate = pn >= 10;
            const int col0 = pn * BM + wc * 32 + 8 * fq;
#pragma unroll
            for (int ai = 0; ai < 2; ++ai)
#pragma unroll
                for (int m = 0; m < 4; ++m) { bf16_t* rowp = P + (size_t)(row0 + ai * HALF + m * 16) * ldc + col0;
#pragma unroll
                    for (int bj = 0; bj < 2; ++bj) { f32x4 v0 = acc[ai][bj][m][0], v1 = acc[ai][bj][m][1];
                        if (gate) {
#pragma unroll
                            for (int i = 0; i < 4; ++i) { v0[i] = sigmoidf_(v0[i]); v1[i] = sigmoidf_(v1[i]); } }
                        *(u32x4*)(rowp + bj * HALF) = pack8(v0, v1); } }
        }
    }
};

struct EpiMerge {
    static constexpr bool PERM = true, AFTER_DRAIN = false;
    bf16_t* MG; const bf16_t* P; int ldp; int goff; int accum;
    __device__ __forceinline__ void operator()(const f32x4 (&acc)[2][2][4][2], const Unit& u, int wr, int wc, int fr, int fq) const {
        const int row0 = u.pm * BM + wr * 64 + fr, col0 = u.pn * BM + wc * 32 + 8 * fq;
#pragma unroll
        for (int ai = 0; ai < 2; ++ai) {
            u32x4 gw[4][2], ov[4][2];
#pragma unroll
            for (int m = 0; m < 4; ++m)
#pragma unroll
                for (int bj = 0; bj < 2; ++bj) { const size_t row = (size_t)(row0 + ai * HALF + m * 16);
                    gw[m][bj] = *(const u32x4*)(P + row * ldp + goff + col0 + bj * HALF);
                    if (accum) ov[m][bj] = *(const u32x4*)(MG + row * 1024 + col0 + bj * HALF); }
#pragma unroll
            for (int m = 0; m < 4; ++m)
#pragma unroll
                for (int bj = 0; bj < 2; ++bj) { const size_t row = (size_t)(row0 + ai * HALF + m * 16);
                    const u32x4 g = gw[m][bj];
                    f32x4 v0 = acc[ai][bj][m][0], v1 = acc[ai][bj][m][1];
                    v0[0] *= bf_lo(g.x); v0[1] *= bf_hi(g.x); v0[2] *= bf_lo(g.y); v0[3] *= bf_hi(g.y);
                    v1[0] *= bf_lo(g.z); v1[1] *= bf_hi(g.z); v1[2] *= bf_lo(g.w); v1[3] *= bf_hi(g.w);
                    if (accum) { const u32x4 o = ov[m][bj];
                        v0[0] += bf_lo(o.x); v0[1] += bf_hi(o.x); v0[2] += bf_lo(o.y); v0[3] += bf_hi(o.y);
                        v1[0] += bf_lo(o.z); v1[1] += bf_hi(o.z); v1[2] += bf_lo(o.w); v1[3] += bf_hi(o.w); }
                    *(u32x4*)(MG + row * 1024 + col0 + bj * HALF) = pack8(v0, v1); }
        }
    }
};

struct EpiOut {
    static constexpr bool PERM = true, AFTER_DRAIN = false;
    const float* baseL; float* outL; const float* baseC; float* outC; const float* gate;
    __device__ __forceinline__ void operator()(const f32x4 (&acc)[2][2][4][2], const Unit& u, int wr, int wc, int fr, int fq) const {
        const int col0 = u.pn * BM + wc * 32 + 8 * fq;
        const bool lat = u.pm < 64;
        const int j = lat ? (u.pm >> 4) : 4;
        const float* base = lat ? baseL : baseC; float* out = lat ? outL : outC;
        const int row0 = (lat ? u.pm : (u.pm - 64)) * BM + wr * 64 + fr;
        f32x4 gv[2][2];
#pragma unroll
        for (int bj = 0; bj < 2; ++bj)
#pragma unroll
            for (int n = 0; n < 2; ++n) gv[bj][n] = *(const f32x4*)(gate + (size_t)j * 6144 + col0 + bj * HALF + n * 4);
#pragma unroll
        for (int am = 0; am < 4; ++am) { const int ai = am >> 1, m0 = (am & 1) * 2;
            f32x4 bv[2][2][2];
#pragma unroll
            for (int mm = 0; mm < 2; ++mm) { const size_t off = (size_t)(row0 + ai * HALF + (m0 + mm) * 16) * 1024 + col0;
#pragma unroll
                for (int bj = 0; bj < 2; ++bj)
#pragma unroll
                    for (int n = 0; n < 2; ++n) bv[mm][bj][n] = *(const f32x4*)(base + off + bj * HALF + n * 4); }
#pragma unroll
            for (int mm = 0; mm < 2; ++mm) { const size_t off = (size_t)(row0 + ai * HALF + (m0 + mm) * 16) * 1024 + col0;
#pragma unroll
                for (int bj = 0; bj < 2; ++bj)
#pragma unroll
                    for (int n = 0; n < 2; ++n) *(f32x4*)(out + off + bj * HALF + n * 4) = bv[mm][bj][n] + gv[bj][n] * acc[ai][bj][m0 + mm][n]; }
        }
    }
};

struct EpiMoe1 {
    static constexpr bool PERM = true, AFTER_DRAIN = false;
    bf16_t* ACT;
    __device__ __forceinline__ void operator()(const f32x4 (&acc)[2][2][4][2], const Unit& u, int wr, int wc, int fr, int fq) const {
        const int row0 = u.pm * BM + wr * 64 + fr, col0 = u.pn * HALF + wc * 32 + 8 * fq;
#pragma unroll
        for (int ai = 0; ai < 2; ++ai)
#pragma unroll
            for (int m = 0; m < 4; ++m) { f32x4 v[2];
#pragma unroll
                for (int n = 0; n < 2; ++n)
#pragma unroll
                    for (int i = 0; i < 4; ++i) { const float a = acc[ai][0][m][n][i], b = acc[ai][1][m][n][i]; v[n][i] = a * sigmoidf_(a) * b; }
                *(u32x4*)(ACT + (size_t)(row0 + ai * HALF + m * 16) * 512 + col0) = pack8(v[0], v[1]); }
    }
};


template <class Epi, class Sched, bool ALIGN_EPI = false, bool SP2 = false>
__device__ __forceinline__ void gemm_phase(PG8_LAS unsigned char* lds, const Gemm g, const Sched& S, const Epi& E) {
    int tid_ = threadIdx.x; asm volatile("" : "+v"(tid_));
    const int tid = tid_, wid = __builtin_amdgcn_readfirstlane(tid >> 6), lane = tid & 63, wr = wid >> 2, wc = wid & 3, fr = lane & 15, fq = lane >> 4;
    const int K = g.K, nt = K / BK;
    unsigned voffA[2], voffB[2];
#pragma unroll
    for (int i = 0; i < 2; ++i) { int R, C; stage_rc(tid * 16 + i * 8192, R, C); const int Rb = Epi::PERM ? ((R & ~31) + perm32(R & 31)) : R;
        voffA[i] = (unsigned)(R * K + C) * 2u; voffB[i] = (unsigned)(Rb * K + C) * 2u; }
    const size_t kstep = (size_t)(BK * 2);
    const size_t hstep = (size_t)HALF * K * 2;
    const size_t tstep = 2 * hstep;
    const unsigned ldsw = (unsigned)wid * 1024u;
    const int aoff = lds_byte(wr * 64 + fr, fq * 8), boff = lds_byte(wc * 32 + fr, fq * 8);
#define PG8_SA(b, h) (((b) * 2 + (h)) * HTB)
#define PG8_SB(b, h) ((4 + (b) * 2 + (h)) * HTB)
#define PG8_STAGE(bufoff, gbase, voff) do { _Pragma("unroll") for (int _i = 0; _i < 2; ++_i) \
        __builtin_amdgcn_global_load_lds((const unsigned*)((const char*)(gbase) + (voff)[_i]), (PG8_LAS unsigned*)(lds + (bufoff) + ldsw + _i * 8192), 16, 0, 0); } while (0)
#define PG8_LDA(dst, b, h) do { _Pragma("unroll") for (int m = 0; m < 4; ++m) _Pragma("unroll") for (int k = 0; k < 2; ++k) dst[m][k] = *(const PG8_LAS bf16x8*)(lds + PG8_SA(b, h) + aoff + m * 2048 + k * 1024); } while (0)
#define PG8_LDB(dst, b, h) do { _Pragma("unroll") for (int n = 0; n < 2; ++n) _Pragma("unroll") for (int k = 0; k < 2; ++k) dst[n][k] = *(const PG8_LAS bf16x8*)(lds + PG8_SB(b, h) + boff + n * 2048 + k * 1024); } while (0)
#define PG8_MMA(ai, bj, At, Bt) do { __builtin_amdgcn_s_setprio(1); _Pragma("unroll") for (int m = 0; m < 4; ++m) _Pragma("unroll") for (int n = 0; n < 2; ++n) _Pragma("unroll") for (int k = 0; k < 2; ++k) \
        acc[ai][bj][m][n] = __builtin_amdgcn_mfma_f32_16x16x32_bf16(Bt[n][k], At[m][k], acc[ai][bj][m][n], 0, 0, 0); __builtin_amdgcn_s_setprio(0); } while (0)
#define PG8_WAIT_V(n) asm volatile("s_waitcnt vmcnt(" #n ")" ::: "memory")
#define PG8_WAIT_L(n) asm volatile("s_waitcnt lgkmcnt(" #n ")" ::: "memory")
#define PG8_BAR __builtin_amdgcn_s_barrier()
#define PG8_SCHED __builtin_amdgcn_sched_barrier(0)
    Unit cur, nxt; int ui = 0;
    if (!S.next(0, cur)) return;
    f32x4 acc[2][2][4][2];
#pragma unroll
    for (int a = 0; a < 2; ++a)
#pragma unroll
        for (int b = 0; b < 2; ++b)
#pragma unroll
            for (int m = 0; m < 4; ++m)
#pragma unroll
                for (int n = 0; n < 2; ++n) acc[a][b][m][n] = (f32x4){0.f, 0.f, 0.f, 0.f};
    bf16x8 At[4][2], B0[2][2], B1[2][2];
    const char* cA = (const char*)g.A + (size_t)cur.pm * tstep; const char* cB = (const char*)g.Bt + (size_t)cur.pb * tstep;
    S.a_ready(cur);
    if constexpr (SP2) {
        PG8_STAGE(PG8_SB(0, 0), cB, voffB); PG8_STAGE(PG8_SB(0, 1), cB + hstep, voffB); PG8_STAGE(PG8_SA(0, 0), cA, voffA); PG8_STAGE(PG8_SA(0, 1), cA + hstep, voffA);
        if (wr == 1) PG8_BAR;
        PG8_WAIT_V(2); PG8_BAR;
        PG8_STAGE(PG8_SB(1, 0), cB + kstep, voffB); PG8_STAGE(PG8_SA(1, 0), cA + kstep, voffA); PG8_STAGE(PG8_SB(1, 1), cB + hstep + kstep, voffB);
        PG8_WAIT_V(6); PG8_BAR;
    } else {
        PG8_STAGE(PG8_SB(0, 0), cB, voffB); PG8_STAGE(PG8_SA(0, 0), cA, voffA); PG8_STAGE(PG8_SB(0, 1), cB + hstep, voffB); PG8_STAGE(PG8_SA(0, 1), cA + hstep, voffA);
        if (wr == 1) PG8_BAR;
        PG8_WAIT_V(4); PG8_BAR;
        PG8_STAGE(PG8_SB(1, 0), cB + kstep, voffB); PG8_STAGE(PG8_SA(1, 0), cA + kstep, voffA); PG8_STAGE(PG8_SB(1, 1), cB + hstep + kstep, voffB);
        PG8_WAIT_V(6); PG8_BAR;
    }
    for (;;) {
        const bool has_next = S.next(ui + 1, nxt);
        const char* nA = has_next ? (const char*)g.A + (size_t)nxt.pm * tstep : cA; const char* nB = has_next ? (const char*)g.Bt + (size_t)nxt.pb * tstep : cB;
        for (int t = 0; t < nt; t += 2) {
            const bool last = (t == nt - 2);
            const char* a1 = cA + (size_t)(t + 1) * kstep;
            const char* a2 = last ? nA : cA + (size_t)(t + 2) * kstep; const char* b2 = last ? nB : cB + (size_t)(t + 2) * kstep;
            const char* a3 = a2 + kstep; const char* b3 = b2 + kstep;
            if (last && has_next) S.a_ready(nxt);
            if constexpr (SP2) {
            PG8_LDB(B0, 0, 0); PG8_LDB(B1, 0, 1); PG8_SCHED; PG8_LDA(At, 0, 0); PG8_STAGE(PG8_SA(1, 1), a1 + hstep, voffA);
            PG8_WAIT_V(8); PG8_WAIT_L(0); PG8_BAR; PG8_MMA(0, 0, At, B0); PG8_MMA(0, 1, At, B1); PG8_BAR; PG8_SCHED;
            PG8_LDA(At, 0, 1); PG8_STAGE(PG8_SB(0, 0), b2, voffB); PG8_STAGE(PG8_SB(0, 1), b2 + hstep, voffB); PG8_STAGE(PG8_SA(0, 0), a2, voffA);
            PG8_WAIT_V(8); PG8_WAIT_L(0); PG8_BAR; PG8_MMA(1, 0, At, B0); PG8_MMA(1, 1, At, B1); PG8_BAR; PG8_SCHED;
            PG8_LDB(B0, 1, 0); PG8_LDB(B1, 1, 1); PG8_SCHED; PG8_LDA(At, 1, 0); PG8_STAGE(PG8_SA(0, 1), a2 + hstep, voffA);
            PG8_WAIT_V(8); PG8_WAIT_L(0); PG8_BAR; PG8_MMA(0, 0, At, B0); PG8_MMA(0, 1, At, B1); PG8_BAR; PG8_SCHED;
            PG8_LDA(At, 1, 1); PG8_STAGE(PG8_SB(1, 0), b3, voffB); PG8_STAGE(PG8_SB(1, 1), b3 + hstep, voffB); PG8_STAGE(PG8_SA(1, 0), a3, voffA);
            PG8_WAIT_V(8); PG8_WAIT_L(0); PG8_BAR; PG8_MMA(1, 0, At, B0); PG8_MMA(1, 1, At, B1); PG8_BAR; PG8_SCHED;
            } else {
            PG8_LDB(B0, 0, 0); PG8_SCHED; PG8_LDA(At, 0, 0); PG8_STAGE(PG8_SA(1, 1), a1 + hstep, voffA);
            PG8_WAIT_L(8); PG8_BAR; PG8_WAIT_L(0); PG8_MMA(0, 0, At, B0); PG8_BAR; PG8_SCHED;
            PG8_LDB(B1, 0, 1); PG8_STAGE(PG8_SB(0, 0), b2, voffB);
            PG8_BAR; PG8_WAIT_L(0); PG8_MMA(0, 1, At, B1); PG8_BAR;
            PG8_LDA(At, 0, 1); PG8_STAGE(PG8_SA(0, 0), a2, voffA);
            PG8_BAR; PG8_WAIT_L(0); PG8_MMA(1, 0, At, B0); PG8_BAR; PG8_SCHED;
            PG8_STAGE(PG8_SB(0, 1), b2 + hstep, voffB);
            PG8_WAIT_V(6); PG8_BAR; PG8_MMA(1, 1, At, B1); PG8_BAR;
            PG8_LDB(B0, 1, 0); PG8_SCHED; PG8_LDA(At, 1, 0); PG8_STAGE(PG8_SA(0, 1), a2 + hstep, voffA);
            PG8_WAIT_L(8); PG8_BAR; PG8_WAIT_L(0); PG8_MMA(0, 0, At, B0); PG8_BAR; PG8_SCHED;
            PG8_LDB(B1, 1, 1); PG8_STAGE(PG8_SB(1, 0), b3, voffB);
            PG8_BAR; PG8_WAIT_L(0); PG8_MMA(0, 1, At, B1); PG8_BAR;
            PG8_LDA(At, 1, 1); PG8_STAGE(PG8_SA(1, 0), a3, voffA);
            PG8_BAR; PG8_WAIT_L(0); PG8_MMA(1, 0, At, B0); PG8_BAR; PG8_SCHED;
            PG8_STAGE(PG8_SB(1, 1), b3 + hstep, voffB);
            PG8_WAIT_V(6); PG8_BAR; PG8_MMA(1, 1, At, B1); PG8_BAR;
            }
        }
        if constexpr (ALIGN_EPI) { if (wr == 0) PG8_BAR; }
        if constexpr (!Epi::AFTER_DRAIN) { E(acc, cur, wr, wc, fr, fq); S.done(cur); }
        if (!has_next) break;
#pragma unroll
        for (int a = 0; a < 2; ++a)
#pragma unroll
            for (int b = 0; b < 2; ++b)
#pragma unroll
                for (int m = 0; m < 4; ++m)
#pragma unroll
                    for (int n = 0; n < 2; ++n) acc[a][b][m][n] = (f32x4){0.f, 0.f, 0.f, 0.f};
        cur = nxt; cA = nA; cB = nB; ++ui;
        if constexpr (ALIGN_EPI) { if (wr == 1) PG8_BAR; }
    }
    PG8_WAIT_V(0);
    if constexpr (!ALIGN_EPI) { if (wr == 0) PG8_BAR; }
    PG8_BAR;
    if constexpr (Epi::AFTER_DRAIN) { E.fused(acc, cur, wr, wc, fr, fq, lds, wid, lane); S.done(cur); }
#undef PG8_SA
#undef PG8_SB
#undef PG8_STAGE
#undef PG8_LDA
#undef PG8_LDB
#undef PG8_MMA
#undef PG8_WAIT_V
#undef PG8_WAIT_L
#undef PG8_BAR
#undef PG8_SCHED
}
}

#define GAS __attribute__((address_space(1)))
#define LAS __attribute__((address_space(3)))
typedef unsigned short bf16;
typedef unsigned v4u __attribute__((ext_vector_type(4)));
typedef unsigned v2u __attribute__((ext_vector_type(2)));
typedef float f32x4 __attribute__((ext_vector_type(4)));
typedef float f32x2 __attribute__((ext_vector_type(2)));
#define LDS_WAIT() asm volatile("s_waitcnt lgkmcnt(0)" ::: "memory")
#define VM_WAIT() asm volatile("s_waitcnt vmcnt(0)" ::: "memory")

constexpr int D = 1024, NB = 4, SEQ = 4096, CTXL = 256, INW = 5632, DEPTH = 2;
constexpr int ML = NB * SEQ, MC = NB * CTXL, MA = ML + MC;
constexpr int COL_F = 0, COL_Q = 256, COL_K = 768, COL_V = 1280, COL_CX = 1792, COL_CB = 2048, COL_CC = 2304, COL_G = 2560;
constexpr int NE = 16, DE = 512;
constexpr int XG_ROWS = 39168;
constexpr int NWAVES = 8, NT = 512;
constexpr int LDS_BYTES = 163840;
constexpr int LDS_TILE_E = 131072, LDS_MISC = 163840 - 256, LDS_ATAB = 163840 - 512;

constexpr size_t MiB = 1u << 20;
constexpr size_t WS_CTL = 0, CTL_ZERO_BYTES = 65536;
constexpr size_t WS_MOD = 1 * MiB;
constexpr size_t WS_ROPE = WS_MOD + 256 * 1024, WS_TW = WS_MOD + 320 * 1024;
constexpr size_t WS_WIN = 2 * MiB, WS_WF = 13 * MiB, WS_WNA = 14 * MiB, WS_WCV = 15 * MiB, WS_WO = 16 * MiB, WS_W13 = 18 * MiB, WS_W2 = 50 * MiB;
constexpr size_t WS_H = 66 * MiB;
constexpr size_t WS_ATT = 100 * MiB, WS_FY = 117 * MiB, WS_YCV = 134 * MiB, WS_CTXN = 143 * MiB, WS_ROUTE = 151 * MiB;
constexpr size_t WS_P = 152 * MiB;
constexpr size_t WS_XG = 152 * MiB, WS_ACT = 229 * MiB, WS_Y = 268 * MiB;
constexpr size_t WS_END = WS_Y + (size_t)XG_ROWS * 1024 * 2;
static_assert(WS_P + (size_t)MA * INW * 2 <= 340 * MiB && WS_XG + (size_t)XG_ROWS * 2048 <= WS_ACT && WS_ACT + (size_t)XG_ROWS * 1024 <= WS_Y, "ws map");
constexpr int CW_CNT = 64;
constexpr int CW_BAR = 4096;

__device__ __forceinline__ unsigned f2bf(float f) { unsigned u = __builtin_bit_cast(unsigned, f); return (u + 0x7fffu + ((u >> 16) & 1u)) >> 16; }
__device__ __forceinline__ unsigned pk2(float lo, float hi) { return f2bf(lo) | (f2bf(hi) << 16); }
__device__ __forceinline__ float bf2f(unsigned short h) { return __builtin_bit_cast(float, (unsigned)h << 16); }
#define DPPF(v, ctrl) __builtin_bit_cast(float, __builtin_amdgcn_update_dpp(0, __builtin_bit_cast(int, (v)), (ctrl), 0xF, 0xF, true))
#define DPP_XOR1 0xB1
#define DPP_XOR2 0x4E
#define DPP_HMIRROR 0x141
#define DPP_MIRROR 0x140
__device__ __forceinline__ float swap16_sum(float a, float b) { const auto r = __builtin_amdgcn_permlane16_swap(__builtin_bit_cast(unsigned, a), __builtin_bit_cast(unsigned, b), false, false); unsigned r0 = r[0], r1 = r[1]; asm volatile("" : "+v"(r0), "+v"(r1)); return __builtin_bit_cast(float, r0) + __builtin_bit_cast(float, r1); }
__device__ __forceinline__ float swap32_sum(float a, float b) { const auto r = __builtin_amdgcn_permlane32_swap(__builtin_bit_cast(unsigned, a), __builtin_bit_cast(unsigned, b), false, false); unsigned r0 = r[0], r1 = r[1]; asm volatile("" : "+v"(r0), "+v"(r1)); return __builtin_bit_cast(float, r0) + __builtin_bit_cast(float, r1); }
__device__ __forceinline__ float wave_sum(float v) {
    v += DPPF(v, DPP_XOR1); v += DPPF(v, DPP_XOR2); v += DPPF(v, DPP_HMIRROR); v += DPPF(v, DPP_MIRROR);
    { float b = v; asm volatile("" : "+v"(b)); v = swap16_sum(v, b); }
    { float b = v; asm volatile("" : "+v"(b)); v = swap32_sum(v, b); }
    return v;
}
__device__ __forceinline__ float wave_max(float v) {
#pragma unroll
    for (int o = 1; o < 64; o <<= 1) v = fmaxf(v, __shfl_xor(v, o));
    return v;
}

struct Args {
    const float *x, *c, *ctx, *c_ctx, *ada_w, *ada_b, *norm1_g, *w_in, *qn_g, *kn_g, *rpb, *conv_w, *w_f, *w_na, *w_cv, *w_o, *norm2_g, *router_w, *router_b, *w1, *w3, *w2;
    float* out; unsigned char* ws; int ph_lo, ph_hi;
};

struct Frame {
    LAS unsigned char* lds;
    int tid, lane, wave, G, bid, gw, NGW;
};

__device__ __forceinline__ unsigned long long ldp(LAS unsigned char* lds, int i) {
    const volatile LAS unsigned* t = (const volatile LAS unsigned*)(lds + LDS_ATAB);
    const unsigned lo = __builtin_amdgcn_readfirstlane(t[2 * i]), hi = __builtin_amdgcn_readfirstlane(t[2 * i + 1]);
    return ((unsigned long long)hi << 32) | lo;
}
__device__ __forceinline__ Args load_args(LAS unsigned char* lds) {
    Args a;
    a.x = (const float*)(const GAS float*)ldp(lds, 0); a.c = (const float*)(const GAS float*)ldp(lds, 1); a.ctx = (const float*)(const GAS float*)ldp(lds, 2); a.c_ctx = (const float*)(const GAS float*)ldp(lds, 3);
    a.ada_w = (const float*)(const GAS float*)ldp(lds, 4); a.ada_b = (const float*)(const GAS float*)ldp(lds, 5); a.norm1_g = (const float*)(const GAS float*)ldp(lds, 6); a.w_in = (const float*)(const GAS float*)ldp(lds, 7);
    a.qn_g = (const float*)(const GAS float*)ldp(lds, 8); a.kn_g = (const float*)(const GAS float*)ldp(lds, 9); a.rpb = (const float*)(const GAS float*)ldp(lds, 10); a.conv_w = (const float*)(const GAS float*)ldp(lds, 11);
    a.w_f = (const float*)(const GAS float*)ldp(lds, 12); a.w_na = (const float*)(const GAS float*)ldp(lds, 13); a.w_cv = (const float*)(const GAS float*)ldp(lds, 14); a.w_o = (const float*)(const GAS float*)ldp(lds, 15);
    a.norm2_g = (const float*)(const GAS float*)ldp(lds, 16); a.router_w = (const float*)(const GAS float*)ldp(lds, 17); a.router_b = (const float*)(const GAS float*)ldp(lds, 18);
    a.w1 = (const float*)(const GAS float*)ldp(lds, 19); a.w3 = (const float*)(const GAS float*)ldp(lds, 20); a.w2 = (const float*)(const GAS float*)ldp(lds, 21);
    a.out = (float*)(GAS float*)ldp(lds, 22); a.ws = (unsigned char*)(GAS unsigned char*)ldp(lds, 23); a.ph_lo = 0; a.ph_hi = 0;
    return a;
}

__device__ __forceinline__ void tr_tile64(const float* Wp, int ldw, bf16* WT0, bf16* WT1, int ldo, LAS float* scr, int lane) {
    f32x4 v[16];
#pragma unroll
    for (int i = 0; i < 16; ++i) v[i] = *(const f32x4*)(Wp + (size_t)(4 * i + (lane >> 4)) * ldw + (lane & 15) * 4);
#pragma unroll
    for (int i = 0; i < 16; ++i) { LAS float* d = scr + (4 * i + (lane >> 4)) * 65 + (lane & 15) * 4; d[0] = v[i].x; d[1] = v[i].y; d[2] = v[i].z; d[3] = v[i].w; }
    LDS_WAIT(); asm volatile("" ::: "memory");
    const int c = lane & 7;
#pragma unroll
    for (int j = 0; j < 8; ++j) { const int n = (lane >> 3) + 8 * j; const LAS float* sp = scr + (8 * c) * 65 + n;
        v4u o; o.x = pk2(sp[0 * 65], sp[1 * 65]); o.y = pk2(sp[2 * 65], sp[3 * 65]); o.z = pk2(sp[4 * 65], sp[5 * 65]); o.w = pk2(sp[6 * 65], sp[7 * 65]);
        bf16* dst = (n < 32) ? WT0 + (size_t)n * ldo : WT1 + (size_t)(n - 32) * ldo;
        *(v4u*)(dst + 8 * c) = o; }
    LDS_WAIT(); asm volatile("" ::: "memory");
}

__device__ __forceinline__ void convert_weights(const Frame& F, int l) {
    const Args a = load_args(F.lds);
    LAS float* scr = (LAS float*)(F.lds + F.wave * 16640);
    unsigned char* ws = a.ws;
    bf16* WIN = (bf16*)(ws + WS_WIN); bf16* WNA = (bf16*)(ws + WS_WNA); bf16* WCV = (bf16*)(ws + WS_WCV); bf16* WO = (bf16*)(ws + WS_WO);
    bf16* W13 = (bf16*)(ws + WS_W13); bf16* W2 = (bf16*)(ws + WS_W2); bf16* WF = (bf16*)(ws + WS_WF);
    constexpr int I_IN = 16 * 88, I_NA = 8 * 16, I_CV = 4 * 16, I_O = 16 * 16, I_E1 = 16 * 128, I_E2 = 16 * 128;
    constexpr int NITEMS = I_IN + I_NA + I_CV + I_O + 2 * I_E1 + I_E2;
    __syncthreads();
    for (int it = F.gw; it < NITEMS; it += F.NGW) {
        int r = it;
        if (r < I_IN) { const int kb = r / 88, nb = r % 88, n0 = 64 * nb, k0 = 64 * kb;
            int d0 = n0, d1 = n0 + 32;
            if (n0 >= COL_Q && n0 < COL_V) { const int pn = n0 >> 8, wc = (n0 & 255) >> 6; d0 = pn * 256 + 32 * wc; d1 = d0 + 128; }
            tr_tile64(a.w_in + (size_t)l * D * INW + (size_t)k0 * INW + n0, INW, WIN + (size_t)d0 * D + k0, WIN + (size_t)d1 * D + k0, D, scr, F.lane); continue; }
        r -= I_IN;
        if (r < I_NA) { const int kb = r / 16, nb = r % 16; bf16* o = WNA + (size_t)(64 * nb) * 512 + 64 * kb; tr_tile64(a.w_na + (size_t)l * 512 * D + (size_t)(64 * kb) * D + 64 * nb, D, o, o + 32 * 512, 512, scr, F.lane); continue; }
        r -= I_NA;
        if (r < I_CV) { const int kb = r / 16, nb = r % 16; bf16* o = WCV + (size_t)(64 * nb) * 256 + 64 * kb; tr_tile64(a.w_cv + (size_t)l * 256 * D + (size_t)(64 * kb) * D + 64 * nb, D, o, o + 32 * 256, 256, scr, F.lane); continue; }
        r -= I_CV;
        if (r < I_O) { const int kb = r / 16, nb = r % 16; bf16* o = WO + (size_t)(64 * nb) * D + 64 * kb; tr_tile64(a.w_o + (size_t)l * D * D + (size_t)(64 * kb) * D + 64 * nb, D, o, o + 32 * D, D, scr, F.lane); continue; }
        r -= I_O;
        if (r < 2 * I_E1) { const int which = r / I_E1; r -= which * I_E1; const int e = r >> 7, q = r & 127, kb = q >> 3, nb = q & 7, n0 = 64 * nb;
            const float* W = (which ? a.w3 : a.w1) + ((size_t)(l * NE + e) * D + 64 * kb) * DE + n0;
            const int drow = (n0 >> 7) * 256 + which * 128 + (n0 & 127);
            bf16* o = W13 + (size_t)e * D * D + (size_t)drow * D + 64 * kb;
            tr_tile64(W, DE, o, o + 32 * D, D, scr, F.lane); continue; }
        r -= 2 * I_E1;
        { const int e = r >> 7, q = r & 127, kb = q >> 4, nb = q & 15;
          bf16* o = W2 + (size_t)e * D * DE + (size_t)(64 * nb) * DE + 64 * kb;
          tr_tile64(a.w2 + ((size_t)(l * NE + e) * DE + 64 * kb) * D + 64 * nb, D, o, o + 32 * DE, DE, scr, F.lane); }
    }
    const float* wf = a.w_f + (size_t)l * 256 * D;
    for (int o = F.bid * NT + F.tid; o < 512 * 1024; o += F.G * NT) {
        const int n = o & 1023, kk = o >> 10, cc = kk & 63, g = (kk >> 6) & 3; const bool sn = kk >= 256;
        float s = 0.f;
#pragma unroll 8
        for (int m = 0; m < 64; ++m) { const int idx = (m * cc) & 63; float sv, cv; __sincosf((float)idx * 0.09817477042468103f, &sv, &cv);
            s += (sn ? sv : cv) * wf[(size_t)(g * 64 + m) * D + n]; }
        WF[(size_t)n * 512 + kk] = (bf16)f2bf(s * 0.125f);
    }
}

__device__ __forceinline__ void phase_prologue(const Frame& F) {
    const Args a = load_args(F.lds);
    float2* rope = (float2*)(a.ws + WS_ROPE); float2* tw = (float2*)(a.ws + WS_TW); float* mod = (float*)(a.ws + WS_MOD);
    const int gt = F.bid * NT + F.tid, GT = F.G * NT;
    for (int i = gt; i < 1024; i += GT) { const int pos = i >> 4, f = i & 15; const float inv = powf(10000.0f, -(float)f / 16.0f); const float ang = (float)pos * inv; rope[i] = make_float2(cosf(ang), sinf(ang)); }
    for (int i = gt; i < 4096; i += GT) { const float ang = (float)i * (6.283185307179586f / 4096.0f); tw[i] = make_float2(cosf(ang), sinf(ang)); }
    if (F.bid < 192) {
        LAS float* s = (LAS float*)(F.lds + 70000);
        LAS float* red = (LAS float*)(F.lds + 70000 + 20480);
        for (int i = F.tid; i < 5 * 1024; i += NT) { const int j = i >> 10, k = i & 1023; const float v = (j < 4) ? a.c[j * 1024 + k] : a.c_ctx[k]; s[i] = v / (1.0f + __expf(-v)); }
        __syncthreads();
        for (int it = F.bid; it < 192; it += F.G) {
            const int l = it / 96, n0 = (it % 96) * 64;
            float acc[5] = {0.f, 0.f, 0.f, 0.f, 0.f};
            const float* w = a.ada_w + ((size_t)l * 1024 + F.wave * 128) * 6144 + n0 + F.lane;
#pragma unroll 1
            for (int k0 = 0; k0 < 128; k0 += 16) { float wv[16];
#pragma unroll
                for (int k = 0; k < 16; ++k) wv[k] = w[(size_t)(k0 + k) * 6144];
#pragma unroll
                for (int k = 0; k < 16; ++k)
#pragma unroll
                    for (int j = 0; j < 5; ++j) acc[j] += s[j * 1024 + F.wave * 128 + k0 + k] * wv[k]; }
#pragma unroll
            for (int j = 0; j < 5; ++j) red[(F.wave * 5 + j) * 64 + F.lane] = acc[j];
            __syncthreads();
            if (F.tid < 320) { const int j = F.tid >> 6, ln = F.tid & 63; float t = a.ada_b[l * 6144 + n0 + ln];
                for (int w8 = 0; w8 < 8; ++w8) t += red[(w8 * 5 + j) * 64 + ln];
                mod[(size_t)(l * 5 + j) * 6144 + n0 + ln] = t; }
            __syncthreads();
        }
    }
    convert_weights(F, 0);
}

__device__ __forceinline__ void norm_mod_store(f32x4 (&v)[4], const float* g, const float* sh, const float* sc, bf16* orow, int lane) {
    float s = 0.f;
#pragma unroll
    for (int j = 0; j < 4; ++j) s += (v[j].x * v[j].x + v[j].y * v[j].y) + (v[j].z * v[j].z + v[j].w * v[j].w);
    const float rstd = 1.0f / sqrtf(wave_sum(s) * (1.0f / 1024.0f) + 1e-6f);
#pragma unroll
    for (int j = 0; j < 4; ++j) { const int k = 4 * lane + 256 * j;
        const f32x4 gg = *(const f32x4*)(g + k), ss = *(const f32x4*)(sh + k), cc = *(const f32x4*)(sc + k);
        const f32x4 y = v[j] * rstd * gg * (cc + 1.0f) + ss;
        v[j] = y;
        *(v2u*)(orow + k) = (v2u){pk2(y.x, y.y), pk2(y.z, y.w)}; }
}

__device__ __forceinline__ void phase_norm_a0(const Frame& F) {
    const Args a = load_args(F.lds);
    const float* mod = (const float*)(a.ws + WS_MOD); bf16* H = (bf16*)(a.ws + WS_H);
#pragma unroll 1
    for (int r0 = F.gw; r0 < MA; r0 += 4 * F.NGW) {
        f32x4 v[4][4];
#pragma unroll
        for (int i = 0; i < 4; ++i) { const int r = r0 + i * F.NGW; if (r < MA) { const float* src = (r < ML) ? a.x + (size_t)r * D : a.ctx + (size_t)(r - ML) * D;
#pragma unroll
            for (int q = 0; q < 4; ++q) v[i][q] = *(const f32x4*)(src + 4 * F.lane + 256 * q); } }
#pragma unroll
        for (int i = 0; i < 4; ++i) { const int r = r0 + i * F.NGW; if (r < MA) { const int j = (r < ML) ? (r >> 12) : 4; const float* m = mod + (size_t)j * 6144;
            norm_mod_store(v[i], a.norm1_g, m, m + 1024, H + (size_t)r * D, F.lane); } }
    }
}

__device__ __forceinline__ void phase_conv(const Frame& F, int l) {
    const Args a = load_args(F.lds);
    const bf16* P = (const bf16*)(a.ws + WS_P); bf16* Y = (bf16*)(a.ws + WS_YCV);
    const float* cw = a.conv_w + l * 3 * 256;
    const int rows = (l == 0) ? MA : ML;
    for (int o = F.bid * NT + F.tid; o < rows * 32; o += F.G * NT) {
        const int r = o >> 5, c0 = (o & 31) * 8;
        int tpos, len; if (r < ML) { tpos = r & 4095; len = 4096; } else { tpos = (r - ML) & 255; len = 256; }
        const bf16* pr = P + (size_t)r * INW;
        float u0[8], u1[8], u2[8], bg[8];
        { const v4u x = *(const v4u*)(pr + COL_CX + c0), c = *(const v4u*)(pr + COL_CC + c0), b = *(const v4u*)(pr + COL_CB + c0);
          const unsigned xs[4] = {x.x, x.y, x.z, x.w}, cs[4] = {c.x, c.y, c.z, c.w}, bs[4] = {b.x, b.y, b.z, b.w};
#pragma unroll
          for (int q = 0; q < 4; ++q) { u1[2 * q] = pg8::bf_lo(xs[q]) * pg8::bf_lo(cs[q]); u1[2 * q + 1] = pg8::bf_hi(xs[q]) * pg8::bf_hi(cs[q]); bg[2 * q] = pg8::bf_lo(bs[q]); bg[2 * q + 1] = pg8::bf_hi(bs[q]); } }
        if (tpos > 0) { const v4u x = *(const v4u*)(pr - INW + COL_CX + c0), c = *(const v4u*)(pr - INW + COL_CC + c0);
          const unsigned xs[4] = {x.x, x.y, x.z, x.w}, cs[4] = {c.x, c.y, c.z, c.w};
#pragma unroll
          for (int q = 0; q < 4; ++q) { u0[2 * q] = pg8::bf_lo(xs[q]) * pg8::bf_lo(cs[q]); u0[2 * q + 1] = pg8::bf_hi(xs[q]) * pg8::bf_hi(cs[q]); } }
        else {
#pragma unroll
          for (int q = 0; q < 8; ++q) u0[q] = 0.f; }
        if (tpos < len - 1) { const v4u x = *(const v4u*)(pr + INW + COL_CX + c0), c = *(const v4u*)(pr + INW + COL_CC + c0);
          const unsigned xs[4] = {x.x, x.y, x.z, x.w}, cs[4] = {c.x, c.y, c.z, c.w};
#pragma unroll
          for (int q = 0; q < 4; ++q) { u2[2 * q] = pg8::bf_lo(xs[q]) * pg8::bf_lo(cs[q]); u2[2 * q + 1] = pg8::bf_hi(xs[q]) * pg8::bf_hi(cs[q]); } }
        else {
#pragma unroll
          for (int q = 0; q < 8; ++q) u2[q] = 0.f; }
        float y[8];
#pragma unroll
        for (int q = 0; q < 8; ++q) y[q] = bg[q] * (cw[c0 + q] * u0[q] + cw[256 + c0 + q] * u1[q] + cw[512 + c0 + q] * u2[q]);
        *(v4u*)(Y + (size_t)r * 256 + c0) = (v4u){pk2(y[0], y[1]), pk2(y[2], y[3]), pk2(y[4], y[5]), pk2(y[6], y[7])};
    }
}

__device__ __forceinline__ void phase_attn_simple(const Frame& F, int l) {
    const Args a = load_args(F.lds);
    const bf16* P = (const bf16*)(a.ws + WS_P); bf16* ATT = (bf16*)(a.ws + WS_ATT);
    LAS bf16* Ks = (LAS bf16*)(F.lds);
    LAS bf16* Vs = (LAS bf16*)(F.lds + 67584);
    LAS float* pb = (LAS float*)(F.lds + 133120) + F.wave * 256;
    LAS float* st = (LAS float*)(F.lds + 141312) + F.wave * 8 * 66;
    const float* rpb = a.rpb + (size_t)l * 8 * 15 * 31;
    const int nItems = 2048 + (l == 0 ? 128 : 0);
    for (int it = F.bid; it < nItems; it += F.G) {
        int b, r = 0, h, qrow0, rs = 0; bool local;
        if (it < 2048) { b = it >> 9; r = (it >> 3) & 63; h = it & 7; qrow0 = b * 4096 + r * 64; local = true; rs = r - 4; rs = rs < 0 ? 0 : (rs > 56 ? 56 : rs); }
        else { const int j = it - 2048; b = j >> 5; h = (j >> 2) & 7; qrow0 = ML + b * 256 + (j & 3) * 64; local = false; }
        for (int i = F.lane; i < 8 * 66; i += 64) { const int q = i / 66, e = i % 66; st[i] = (e == 64) ? -1e30f : 0.f; }
        for (int stage = local ? 0 : 1; stage < 2; ++stage) {
            __syncthreads();
            const int nk = stage == 0 ? 512 : 256;
            const size_t krow0 = stage == 0 ? (size_t)b * 4096 + rs * 64 : (size_t)ML + b * 256;
            for (int i = F.tid; i < nk * 8; i += NT) { const int key = i >> 3, ch = i & 7;
                const bf16* src = P + (krow0 + key) * INW + h * 64 + ch * 8;
                const v4u kv = *(const v4u*)(src + COL_K), vv = *(const v4u*)(src + COL_V);
                LAS unsigned* kd = (LAS unsigned*)(Ks + key * 66 + ch * 8); kd[0] = kv.x; kd[1] = kv.y; kd[2] = kv.z; kd[3] = kv.w;
                *(LAS v4u*)(Vs + key * 64 + ch * 8) = vv; }
            __syncthreads();
            for (int q = 0; q < 8; ++q) {
                const int qi = F.wave * 8 + q;
                float qv[64];
                { const bf16* qp = P + (size_t)(qrow0 + qi) * INW + COL_Q + h * 64;
#pragma unroll
                  for (int c = 0; c < 8; ++c) { const v4u w = *(const v4u*)(qp + c * 8); const unsigned ws4[4] = {w.x, w.y, w.z, w.w};
#pragma unroll
                      for (int e = 0; e < 4; ++e) { qv[c * 8 + 2 * e] = pg8::bf_lo(ws4[e]); qv[c * 8 + 2 * e + 1] = pg8::bf_hi(ws4[e]); } } }
                int cs = qi - 8; cs = cs < 0 ? 0 : (cs > 48 ? 48 : cs);
                const int nch = stage == 0 ? 2 : 4;
                float sc[4]; float mx = -1e30f;
#pragma unroll
                for (int c = 0; c < 4; ++c) { sc[c] = -1e30f;
                    if (c < nch) {
                        int kidx; float bias = 0.f;
                        if (stage == 0) { const int i = c * 4 + (F.lane >> 4), kc = cs + (F.lane & 15); kidx = i * 64 + kc; bias = rpb[(h * 15 + (rs + i - r + 7)) * 31 + (kc - qi + 15)]; }
                        else kidx = c * 64 + F.lane;
                        const LAS unsigned* kp = (const LAS unsigned*)(Ks + kidx * 66);
                        float d = 0.f;
#pragma unroll
                        for (int e = 0; e < 32; ++e) { const unsigned w = kp[e]; d += qv[2 * e] * pg8::bf_lo(w) + qv[2 * e + 1] * pg8::bf_hi(w); }
                        sc[c] = d * 0.125f + bias; mx = fmaxf(mx, sc[c]); } }
                mx = wave_max(mx);
                const float m_old = st[q * 66 + 64], l_old = st[q * 66 + 65], o_old = st[q * 66 + F.lane];
                const float m_new = fmaxf(m_old, mx), alpha = __expf(m_old - m_new);
                float psum = 0.f;
#pragma unroll
                for (int c = 0; c < 4; ++c) if (c < nch) { const float p = __expf(sc[c] - m_new); psum += p; pb[c * 64 + F.lane] = p; }
                psum = wave_sum(psum);
                LDS_WAIT(); asm volatile("" ::: "memory");
                float o = o_old * alpha;
                const int nkq = nch * 64;
                for (int j = 0; j < nkq; ++j) {
                    int kidx; if (stage == 0) { const int c = j >> 6, ln = j & 63; kidx = (c * 4 + (ln >> 4)) * 64 + cs + (ln & 15); } else kidx = j;
                    o += pb[j] * bf2f(Vs[kidx * 64 + F.lane]); }
                st[q * 66 + F.lane] = o;
                if (F.lane == 0) { st[q * 66 + 64] = m_new; st[q * 66 + 65] = l_old * alpha + psum; }
                LDS_WAIT(); asm volatile("" ::: "memory");
            }
        }
        for (int q = 0; q < 8; ++q) { const int qi = F.wave * 8 + q; const float o = st[q * 66 + F.lane] / st[q * 66 + 65];
            ATT[(size_t)(qrow0 + qi) * 512 + h * 64 + F.lane] = (bf16)f2bf(o); }
        LDS_WAIT(); asm volatile("" ::: "memory");
    }
    __syncthreads();
}

typedef short v4i16_t __attribute__((ext_vector_type(4)));
typedef float f32x16 __attribute__((ext_vector_type(16)));
__device__ __forceinline__ void phase_attn_mfma(const Frame& F, int l) {
    const Args a = load_args(F.lds);
    const bf16* P = (const bf16*)(a.ws + WS_P); bf16* ATT = (bf16*)(a.ws + WS_ATT);
    LAS unsigned char* wl = F.lds + F.wave * 18432;
    LAS unsigned char* Kl = wl; LAS unsigned char* Vl = wl + 4096; LAS float* rb = (LAS float*)(wl + 8192); LAS unsigned char* Ql = wl + 10240;
    const int h = F.wave, lane = F.lane, q31 = lane & 31, hh = lane >> 5;
    constexpr float LOG2E = 1.4426950408889634f;
    __syncthreads();
    { const float* rp = a.rpb + (size_t)(l * 8 + h) * 465; for (int i = lane; i < 465; i += 64) rb[i] = rp[i] * LOG2E; }
    LDS_WAIT();
    const int lkey = lane >> 3, lch = lane & 7;
    const int tq = (lane & 15) >> 2, tp = lane & 3, gI = (lane >> 4) & 1;
    const int nItems = 256 + (l == 0 ? 16 : 0);
    for (int it = F.bid; it < nItems; it += F.G) {
        int b, r, qrow0, rs, ntile;
        if (it < 256) { b = it >> 6; r = it & 63; qrow0 = b * 4096 + r * 64; rs = r - 4; rs = rs < 0 ? 0 : (rs > 56 ? 56 : rs); ntile = 24; }
        else { const int j = it - 256; b = j >> 2; r = 0; rs = 0; qrow0 = ML + b * 256 + (j & 3) * 64; ntile = 8; }
#pragma unroll
        for (int i = 0; i < 8; ++i) { const int qq = lkey + 8 * i;
            const v4u w = *(const v4u*)(P + (size_t)(qrow0 + qq) * INW + COL_Q + h * 64 + lch * 8);
            const float c = 0.125f * LOG2E;
            v4u o; o.x = pk2(pg8::bf_lo(w.x) * c, pg8::bf_hi(w.x) * c); o.y = pk2(pg8::bf_lo(w.y) * c, pg8::bf_hi(w.y) * c);
            o.z = pk2(pg8::bf_lo(w.z) * c, pg8::bf_hi(w.z) * c); o.w = pk2(pg8::bf_lo(w.w) * c, pg8::bf_hi(w.w) * c);
            *(LAS v4u*)(Ql + qq * 128 + ((lch ^ (qq & 7)) << 4)) = o; }
        f32x16 o[2][2];
#pragma unroll
        for (int qb = 0; qb < 2; ++qb)
#pragma unroll
            for (int dt = 0; dt < 2; ++dt)
#pragma unroll
                for (int e = 0; e < 16; ++e) o[qb][dt][e] = 0.f;
        float mrun[2] = {-INFINITY, -INFINITY}, lrun[2] = {0.f, 0.f};
        v4u kr[4], vr[4];
        {   const size_t row0 = (size_t)ML + b * 256;
#pragma unroll
            for (int i = 0; i < 4; ++i) { const bf16* src = P + (row0 + lkey + 8 * i) * INW + h * 64 + lch * 8; kr[i] = *(const v4u*)(src + COL_K); vr[i] = *(const v4u*)(src + COL_V); } }
#pragma unroll 1
        for (int t = 0; t < ntile; ++t) {
#pragma unroll
            for (int i = 0; i < 4; ++i) { const int key = lkey + 8 * i; const int off = key * 128 + ((lch ^ (key & 7)) << 4); *(LAS v4u*)(Kl + off) = kr[i]; *(LAS v4u*)(Vl + off) = vr[i]; }
            if (t + 1 < ntile) { const int tn = t + 1;
                const size_t row0 = (tn < 8) ? (size_t)ML + b * 256 + 32 * tn : (size_t)b * 4096 + (rs + ((tn - 8) >> 1)) * 64 + 32 * ((tn - 8) & 1);
#pragma unroll
                for (int i = 0; i < 4; ++i) { const bf16* src = P + (row0 + lkey + 8 * i) * INW + h * 64 + lch * 8; kr[i] = *(const v4u*)(src + COL_K); vr[i] = *(const v4u*)(src + COL_V); } }
            pg8::bf16x8 kf[4];
#pragma unroll
            for (int ks = 0; ks < 4; ++ks) kf[ks] = *(const LAS pg8::bf16x8*)(Kl + q31 * 128 + (((2 * ks + hh) ^ (q31 & 7)) << 4));
            pg8::bf16x8 vf[2][2];
#pragma unroll
            for (int dt = 0; dt < 2; ++dt)
#pragma unroll
                for (int s2 = 0; s2 < 2; ++s2) {
                    v4i16_t part[2];
#pragma unroll
                    for (int sec = 0; sec < 2; ++sec) { const int key = 16 * s2 + 8 * sec + 4 * hh + tq; const int ch = 4 * dt + 2 * gI + (tp >> 1);
                        part[sec] = __builtin_amdgcn_ds_read_tr16_b64_v4i16((LAS v4i16_t*)(Vl + key * 128 + ((ch ^ (key & 7)) << 4) + 8 * (tp & 1))); }
                    vf[dt][s2] = (pg8::bf16x8){part[0][0], part[0][1], part[0][2], part[0][3], part[1][0], part[1][1], part[1][2], part[1][3]}; }
            const bool local = t >= 8;
            const int ti = (t - 8) >> 1, tc = (t - 8) & 1, dr = rs + ti - r + 7;
#pragma unroll
            for (int qb = 0; qb < 2; ++qb) {
                f32x16 sa;
#pragma unroll
                for (int e = 0; e < 16; ++e) sa[e] = 0.f;
#pragma unroll
                for (int ks = 0; ks < 4; ++ks) { const pg8::bf16x8 qfr = *(const LAS pg8::bf16x8*)(Ql + (32 * qb + q31) * 128 + (((2 * ks + hh) ^ (q31 & 7)) << 4));
                    sa = __builtin_amdgcn_mfma_f32_32x32x16_bf16(kf[ks], qfr, sa, 0, 0, 0); }
                if (local) {
                    const int qc = 32 * qb + q31; int cs = qc - 8; cs = cs < 0 ? 0 : (cs > 48 ? 48 : cs);
                    float bs[16];
#pragma unroll
                    for (int e = 0; e < 16; ++e) { const int kc = 32 * tc + (e & 3) + 8 * (e >> 2) + 4 * hh; int dc = kc - qc + 15; dc = dc < 0 ? 0 : (dc > 30 ? 30 : dc); bs[e] = rb[dr * 31 + dc]; }
#pragma unroll
                    for (int e = 0; e < 16; ++e) asm volatile("" : "+v"(bs[e]));
#pragma unroll
                    for (int e = 0; e < 16; ++e) { const int kc = 32 * tc + (e & 3) + 8 * (e >> 2) + 4 * hh; sa[e] = ((unsigned)(kc - cs) < 16u) ? sa[e] + bs[e] : -INFINITY; }
                }
                float mx = sa[0];
#pragma unroll
                for (int e = 1; e < 16; ++e) mx = fmaxf(mx, sa[e]);
                { const auto rr = __builtin_amdgcn_permlane32_swap(__builtin_bit_cast(unsigned, mx), __builtin_bit_cast(unsigned, mx), false, false); unsigned r0 = rr[0], r1 = rr[1]; asm volatile("" : "+v"(r0), "+v"(r1));
                  mx = fmaxf(__builtin_bit_cast(float, r0), __builtin_bit_cast(float, r1)); }
                const float mnew = fmaxf(mrun[qb], mx);
                const float alpha = __builtin_amdgcn_exp2f(mrun[qb] - mnew);
                mrun[qb] = mnew;
                float ps = 0.f;
#pragma unroll
                for (int e = 0; e < 16; ++e) { sa[e] = __builtin_amdgcn_exp2f(sa[e] - mnew); ps += sa[e]; }
                lrun[qb] = lrun[qb] * alpha + ps;
#pragma unroll
                for (int dt = 0; dt < 2; ++dt)
#pragma unroll
                    for (int e = 0; e < 16; ++e) o[qb][dt][e] *= alpha;
                v4u p0, p1;
                p0.x = pg8::cvt_pk_bf16(sa[0], sa[1]); p0.y = pg8::cvt_pk_bf16(sa[2], sa[3]); p0.z = pg8::cvt_pk_bf16(sa[4], sa[5]); p0.w = pg8::cvt_pk_bf16(sa[6], sa[7]);
                p1.x = pg8::cvt_pk_bf16(sa[8], sa[9]); p1.y = pg8::cvt_pk_bf16(sa[10], sa[11]); p1.z = pg8::cvt_pk_bf16(sa[12], sa[13]); p1.w = pg8::cvt_pk_bf16(sa[14], sa[15]);
                const pg8::bf16x8 pb0 = __builtin_bit_cast(pg8::bf16x8, p0), pb1 = __builtin_bit_cast(pg8::bf16x8, p1);
#pragma unroll
                for (int dt = 0; dt < 2; ++dt) {
                    o[qb][dt] = __builtin_amdgcn_mfma_f32_32x32x16_bf16(vf[dt][0], pb0, o[qb][dt], 0, 0, 0);
                    o[qb][dt] = __builtin_amdgcn_mfma_f32_32x32x16_bf16(vf[dt][1], pb1, o[qb][dt], 0, 0, 0); }
            }
        }
#pragma unroll
        for (int qb = 0; qb < 2; ++qb) {
            float lt; { float bq = lrun[qb]; asm volatile("" : "+v"(bq)); lt = swap32_sum(lrun[qb], bq); }
            const float inv = 1.0f / lt;
            bf16* orow = ATT + (size_t)(qrow0 + 32 * qb + q31) * 512 + h * 64 + 4 * hh;
#pragma unroll
            for (int dt = 0; dt < 2; ++dt)
#pragma unroll
                for (int g4 = 0; g4 < 4; ++g4) {
                    const v2u w = (v2u){pg8::cvt_pk_bf16(o[qb][dt][4 * g4] * inv, o[qb][dt][4 * g4 + 1] * inv), pg8::cvt_pk_bf16(o[qb][dt][4 * g4 + 2] * inv, o[qb][dt][4 * g4 + 3] * inv)};
                    *(v2u*)(orow + 32 * dt + 8 * g4) = w; }
        }
    }
    __syncthreads();
}

__device__ __forceinline__ void phase_fourier_simple(const Frame& F, int l, bool do_latent) {
    const Args a = load_args(F.lds);
    const bf16* P = (const bf16*)(a.ws + WS_P); bf16* FY = (bf16*)(a.ws + WS_FY);
    const float2* tw = (const float2*)(a.ws + WS_TW);
    LAS float* X = (LAS float*)(F.lds);
    LAS f32x2* Z = (LAS f32x2*)(F.lds + 32768);
    LAS float* c64 = (LAS float*)(F.lds + 32768 + 66048); LAS float* s64 = c64 + 64;
    LAS float* c256 = s64 + 64; LAS float* s256 = c256 + 256;
    __syncthreads();
    if (F.tid < 64) { float sv, cv; sincosf((float)F.tid * 0.09817477042468103f, &sv, &cv); c64[F.tid] = cv; s64[F.tid] = sv; }
    if (F.tid < 256) { float sv, cv; sincosf((float)F.tid * 0.02454369260617026f, &sv, &cv); c256[F.tid] = cv; s256[F.tid] = sv; }
    __syncthreads();
    const int g = F.tid >> 7, lo = F.tid & 127;
    for (int it = F.bid; it < (do_latent ? 512 : 0); it += F.G) {
        const int b = it >> 7, c0 = (it & 127) * 2;
        __syncthreads();
        for (int t = F.tid; t < 4096; t += NT) { const unsigned w = *(const unsigned*)(P + (size_t)(b * 4096 + t) * INW + COL_F + c0); X[2 * t] = pg8::bf_lo(w); X[2 * t + 1] = pg8::bf_hi(w); }
        __syncthreads();
        {
            float ar[16], ai[16];
#pragma unroll
            for (int k = 0; k < 16; ++k) { ar[k] = 0.f; ai[k] = 0.f; }
            for (int t1 = 0; t1 < 64; ++t1) { const float x = X[t1 * 128 + lo];
#pragma unroll
                for (int k = 0; k < 16; ++k) { const int idx = ((g * 16 + k) * t1) & 63; ar[k] += x * c64[idx]; ai[k] -= x * s64[idx]; } }
            const int t2 = lo >> 1;
#pragma unroll
            for (int k = 0; k < 16; ++k) { const int k1 = g * 16 + k; const float2 w = tw[t2 * k1];
                Z[k1 * 129 + lo] = (f32x2){ar[k] * w.x + ai[k] * w.y, ai[k] * w.x - ar[k] * w.y}; }
        }
        __syncthreads();
        {
            float yr[16], yi[16];
#pragma unroll
            for (int k = 0; k < 16; ++k) { yr[k] = 0.f; yi[k] = 0.f; }
            const int k1 = lo >> 1, c = lo & 1;
            for (int t2 = 0; t2 < 64; ++t2) { const f32x2 z = Z[k1 * 129 + t2 * 2 + c];
#pragma unroll
                for (int k = 0; k < 16; ++k) { const int idx = ((g * 16 + k) * t2) & 63; const float cv = c64[idx], sv = s64[idx]; yr[k] += z.x * cv + z.y * sv; yi[k] += z.y * cv - z.x * sv; } }
#pragma unroll
            for (int k = 0; k < 16; ++k) { const int k2 = g * 16 + k; bf16* o = FY + (size_t)(b * 4096 + k1 + 64 * k2) * 512 + c0 + c;
                o[0] = (bf16)f2bf(yr[k] * (1.0f / 64.0f)); o[256] = (bf16)f2bf(yi[k] * (1.0f / 64.0f)); }
        }
    }
    if (l == 0) {
        for (int it = F.bid; it < 512; it += F.G) {
            const int b = it >> 7, c0 = (it & 127) * 2;
            __syncthreads();
            if (F.tid < 256) { const unsigned w = *(const unsigned*)(P + (size_t)(ML + b * 256 + F.tid) * INW + COL_F + c0); X[2 * F.tid] = pg8::bf_lo(w); X[2 * F.tid + 1] = pg8::bf_hi(w); }
            __syncthreads();
            const int k = F.tid >> 1, c = F.tid & 1; float yr = 0.f, yi = 0.f;
            for (int t = 0; t < 256; ++t) { const float x = X[2 * t + c]; const int idx = (k * t) & 255; yr += x * c256[idx]; yi -= x * s256[idx]; }
            bf16* o = FY + (size_t)(ML + b * 256 + k) * 512 + c0 + c;
            o[0] = (bf16)f2bf(yr * (1.0f / 16.0f)); o[256] = (bf16)f2bf(yi * (1.0f / 16.0f));
        }
    }
    __syncthreads();
}

__device__ __forceinline__ pg8::bf16x8 neg_bf16x8(pg8::bf16x8 v) { v4u u = __builtin_bit_cast(v4u, v); u.x ^= 0x80008000u; u.y ^= 0x80008000u; u.z ^= 0x80008000u; u.w ^= 0x80008000u; return __builtin_bit_cast(pg8::bf16x8, u); }
__device__ __forceinline__ void phase_fourier_mfma(const Frame& F, int l) {
    const Args a = load_args(F.lds);
    const bf16* P = (const bf16*)(a.ws + WS_P); bf16* FY = (bf16*)(a.ws + WS_FY);
    const float2* tw = (const float2*)(a.ws + WS_TW);
    LAS unsigned char* Ul = F.lds; LAS unsigned char* Zr = F.lds + 36864; LAS unsigned char* Zi = F.lds + 73728;
    LAS float* c64 = (LAS float*)(F.lds + 110592); LAS float* s64 = c64 + 64;
    __syncthreads();
    if (F.tid < 64) { float sv, cv; sincosf((float)F.tid * 0.09817477042468103f, &sv, &cv); c64[F.tid] = cv; s64[F.tid] = sv; }
    __syncthreads();
    const int lane = F.lane, q31 = lane & 31, hh = lane >> 5, w = F.wave;
    const int tq = (lane & 15) >> 2, tp = lane & 3, gI = (lane >> 4) & 1;
    pg8::bf16x8 Tc[2][4], Ts[2][4];
#pragma unroll
    for (int nt = 0; nt < 2; ++nt)
#pragma unroll
        for (int ks = 0; ks < 4; ++ks) { const int n = 32 * nt + q31; unsigned cw[4], sw[4];
#pragma unroll
            for (int jj = 0; jj < 4; ++jj) { const int k0 = 16 * ks + 8 * hh + 2 * jj; const int i0 = (n * k0) & 63, i1 = (n * (k0 + 1)) & 63;
                cw[jj] = pk2(c64[i0], c64[i1]); sw[jj] = pk2(s64[i0], s64[i1]); }
            Tc[nt][ks] = __builtin_bit_cast(pg8::bf16x8, (v4u){cw[0], cw[1], cw[2], cw[3]}); Ts[nt][ks] = __builtin_bit_cast(pg8::bf16x8, (v4u){sw[0], sw[1], sw[2], sw[3]}); }
    const int troff = (8 * hh + tq) * 576 + (32 * w + 16 * gI + 4 * tp) * 2;
    for (int it = F.bid; it < 256; it += F.G) {
        const int b = it >> 6, c0 = (it & 63) * 4;
        __syncthreads();
        for (int t = F.tid; t < 4096; t += NT) { const v2u x = *(const v2u*)(P + (size_t)(b * 4096 + t) * INW + COL_F + c0); *(LAS v2u*)(Ul + (t >> 6) * 576 + (t & 63) * 8) = x; }
        __syncthreads();
        {   f32x16 ar[2], ai[2];
#pragma unroll
            for (int nt = 0; nt < 2; ++nt)
#pragma unroll
                for (int e = 0; e < 16; ++e) { ar[nt][e] = 0.f; ai[nt][e] = 0.f; }
#pragma unroll
            for (int ks = 0; ks < 4; ++ks) {
                const v4i16_t p0 = __builtin_amdgcn_ds_read_tr16_b64_v4i16((LAS v4i16_t*)(Ul + troff + (16 * ks) * 576));
                const v4i16_t p1 = __builtin_amdgcn_ds_read_tr16_b64_v4i16((LAS v4i16_t*)(Ul + troff + (16 * ks + 4) * 576));
                const pg8::bf16x8 A = (pg8::bf16x8){p0[0], p0[1], p0[2], p0[3], p1[0], p1[1], p1[2], p1[3]};
#pragma unroll
                for (int nt = 0; nt < 2; ++nt) { ar[nt] = __builtin_amdgcn_mfma_f32_32x32x16_bf16(A, Tc[nt][ks], ar[nt], 0, 0, 0);
                    ai[nt] = __builtin_amdgcn_mfma_f32_32x32x16_bf16(A, neg_bf16x8(Ts[nt][ks]), ai[nt], 0, 0, 0); } }
#pragma unroll
            for (int nt = 0; nt < 2; ++nt) { const int k1 = 32 * nt + q31;
#pragma unroll
                for (int g = 0; g < 4; ++g) { const int t2 = 8 * w + 2 * g + hh; const float2 tv = tw[t2 * k1];
                    float zr[4], zi[4];
#pragma unroll
                    for (int c = 0; c < 4; ++c) { const float r0 = ar[nt][4 * g + c], i0 = ai[nt][4 * g + c]; zr[c] = r0 * tv.x + i0 * tv.y; zi[c] = i0 * tv.x - r0 * tv.y; }
                    *(LAS v2u*)(Zr + t2 * 576 + k1 * 8) = (v2u){pg8::cvt_pk_bf16(zr[0], zr[1]), pg8::cvt_pk_bf16(zr[2], zr[3])};
                    *(LAS v2u*)(Zi + t2 * 576 + k1 * 8) = (v2u){pg8::cvt_pk_bf16(zi[0], zi[1]), pg8::cvt_pk_bf16(zi[2], zi[3])}; } }
        }
        __syncthreads();
        {   f32x16 yr[2], yi[2];
#pragma unroll
            for (int nt = 0; nt < 2; ++nt)
#pragma unroll
                for (int e = 0; e < 16; ++e) { yr[nt][e] = 0.f; yi[nt][e] = 0.f; }
#pragma unroll
            for (int ks = 0; ks < 4; ++ks) {
                const v4i16_t r0 = __builtin_amdgcn_ds_read_tr16_b64_v4i16((LAS v4i16_t*)(Zr + troff + (16 * ks) * 576));
                const v4i16_t r1 = __builtin_amdgcn_ds_read_tr16_b64_v4i16((LAS v4i16_t*)(Zr + troff + (16 * ks + 4) * 576));
                const v4i16_t i0 = __builtin_amdgcn_ds_read_tr16_b64_v4i16((LAS v4i16_t*)(Zi + troff + (16 * ks) * 576));
                const v4i16_t i1 = __builtin_amdgcn_ds_read_tr16_b64_v4i16((LAS v4i16_t*)(Zi + troff + (16 * ks + 4) * 576));
                const pg8::bf16x8 Are = (pg8::bf16x8){r0[0], r0[1], r0[2], r0[3], r1[0], r1[1], r1[2], r1[3]};
                const pg8::bf16x8 Aim = (pg8::bf16x8){i0[0], i0[1], i0[2], i0[3], i1[0], i1[1], i1[2], i1[3]};
#pragma unroll
                for (int nt = 0; nt < 2; ++nt) {
                    yr[nt] = __builtin_amdgcn_mfma_f32_32x32x16_bf16(Are, Tc[nt][ks], yr[nt], 0, 0, 0);
                    yr[nt] = __builtin_amdgcn_mfma_f32_32x32x16_bf16(Aim, Ts[nt][ks], yr[nt], 0, 0, 0);
                    yi[nt] = __builtin_amdgcn_mfma_f32_32x32x16_bf16(Aim, Tc[nt][ks], yi[nt], 0, 0, 0);
                    yi[nt] = __builtin_amdgcn_mfma_f32_32x32x16_bf16(Are, neg_bf16x8(Ts[nt][ks]), yi[nt], 0, 0, 0); } }
#pragma unroll
            for (int nt = 0; nt < 2; ++nt)
#pragma unroll
                for (int g = 0; g < 4; ++g) { const int tok = (8 * w + 2 * g + hh) + 64 * (32 * nt + q31);
                    bf16* o = FY + (size_t)(b * 4096 + tok) * 512 + c0; const float sc = 1.0f / 64.0f;
                    *(v2u*)o = (v2u){pg8::cvt_pk_bf16(yr[nt][4 * g] * sc, yr[nt][4 * g + 1] * sc), pg8::cvt_pk_bf16(yr[nt][4 * g + 2] * sc, yr[nt][4 * g + 3] * sc)};
                    *(v2u*)(o + 256) = (v2u){pg8::cvt_pk_bf16(yi[nt][4 * g] * sc, yi[nt][4 * g + 1] * sc), pg8::cvt_pk_bf16(yi[nt][4 * g + 2] * sc, yi[nt][4 * g + 3] * sc)}; }
        }
    }
    __syncthreads();
}

__device__ __forceinline__ void phase_route(const Frame& F, int l) {
    const Args a = load_args(F.lds);
    const float* mod = (const float*)(a.ws + WS_MOD) + (size_t)l * 5 * 6144; bf16* H = (bf16*)(a.ws + WS_H);
    const float* ctxn = (const float*)(a.ws + WS_CTXN);
    int* route = (int*)(a.ws + WS_ROUTE);
    unsigned* cnt = (unsigned*)(a.ws + WS_CTL) + CW_CNT + l * 16 * 64;
    const int rows = (l == 0) ? MA : ML;
    LAS int* lcnt = (LAS int*)(F.lds + 65536); LAS int* lbase = lcnt + 16; LAS int* lrow = lcnt + 64;
    if (F.tid < 16) lcnt[F.tid] = 0;
    LAS float* rwT = (LAS float*)F.lds;
    __syncthreads();
    for (int i = F.tid; i < 4096; i += NT) { const f32x4 w = *(const f32x4*)(a.router_w + (size_t)i * 4); const int k = i >> 2, e0 = (i & 3) * 4;
        rwT[(e0 + 0) * 1024 + k] = w.x; rwT[(e0 + 1) * 1024 + k] = w.y; rwT[(e0 + 2) * 1024 + k] = w.z; rwT[(e0 + 3) * 1024 + k] = w.w; }
    __syncthreads();
    float rbias[16];
#pragma unroll
    for (int e = 0; e < 16; ++e) rbias[e] = a.router_b[e];
    f32x4 nv[4];
    if (F.gw < rows) { const int r = F.gw; const float* src = (r < ML) ? a.out + (size_t)r * D : ctxn + (size_t)(r - ML) * D;
#pragma unroll
        for (int q = 0; q < 4; ++q) nv[q] = *(const f32x4*)(src + 4 * F.lane + 256 * q); }
#pragma unroll 1
    for (int r = F.gw; r < rows; r += F.NGW) {
        const int j = (r < ML) ? (r >> 12) : 4;
        f32x4 v[4];
#pragma unroll
        for (int q = 0; q < 4; ++q) v[q] = nv[q];
        { const int rn = r + F.NGW; if (rn < rows) { const float* src = (rn < ML) ? a.out + (size_t)rn * D : ctxn + (size_t)(rn - ML) * D;
#pragma unroll
            for (int q = 0; q < 4; ++q) nv[q] = *(const f32x4*)(src + 4 * F.lane + 256 * q); } }
        const float* m = mod + (size_t)j * 6144;
        norm_mod_store(v, a.norm2_g + l * 1024, m + 3072, m + 4096, H + (size_t)r * D, F.lane);
        float lg[16];
        {   const unsigned rwaddr = (unsigned)(size_t)rwT + 16u * (unsigned)F.lane;
#define RW8(E) { f32x4 w0, w1, w2, w3, w4, w5, w6, w7; \
            asm volatile("ds_read_b128 %0, %8 offset:%c9\n\tds_read_b128 %1, %8 offset:%c10\n\tds_read_b128 %2, %8 offset:%c11\n\tds_read_b128 %3, %8 offset:%c12\n\t" \
                         "ds_read_b128 %4, %8 offset:%c13\n\tds_read_b128 %5, %8 offset:%c14\n\tds_read_b128 %6, %8 offset:%c15\n\tds_read_b128 %7, %8 offset:%c16\n\ts_waitcnt lgkmcnt(0)" \
                : "=&v"(w0), "=&v"(w1), "=&v"(w2), "=&v"(w3), "=&v"(w4), "=&v"(w5), "=&v"(w6), "=&v"(w7) \
                : "v"(rwaddr), "i"((E) * 4096), "i"((E) * 4096 + 1024), "i"((E) * 4096 + 2048), "i"((E) * 4096 + 3072), \
                  "i"((E) * 4096 + 4096), "i"((E) * 4096 + 5120), "i"((E) * 4096 + 6144), "i"((E) * 4096 + 7168) : "memory"); \
            lg[(E)] = ((v[0].x * w0.x + v[0].y * w0.y) + (v[0].z * w0.z + v[0].w * w0.w)) + ((v[1].x * w1.x + v[1].y * w1.y) + (v[1].z * w1.z + v[1].w * w1.w)) \
                    + ((v[2].x * w2.x + v[2].y * w2.y) + (v[2].z * w2.z + v[2].w * w2.w)) + ((v[3].x * w3.x + v[3].y * w3.y) + (v[3].z * w3.z + v[3].w * w3.w)); \
            lg[(E) + 1] = ((v[0].x * w4.x + v[0].y * w4.y) + (v[0].z * w4.z + v[0].w * w4.w)) + ((v[1].x * w5.x + v[1].y * w5.y) + (v[1].z * w5.z + v[1].w * w5.w)) \
                    + ((v[2].x * w6.x + v[2].y * w6.y) + (v[2].z * w6.z + v[2].w * w6.w)) + ((v[3].x * w7.x + v[3].y * w7.y) + (v[3].z * w7.z + v[3].w * w7.w)); }
            RW8(0) RW8(2) RW8(4) RW8(6) RW8(8) RW8(10) RW8(12) RW8(14)
#undef RW8
        }
        {
            const bool b3 = (F.lane & 8) != 0, b2 = (F.lane & 4) != 0;
            float a8[8], a4[4], a2[2];
#pragma unroll
            for (int i = 0; i < 8; ++i) a8[i] = swap32_sum(lg[i], lg[i + 8]);
#pragma unroll
            for (int i = 0; i < 4; ++i) a4[i] = swap16_sum(a8[i], a8[i + 4]);
#pragma unroll
            for (int i = 0; i < 2; ++i) { const float snd = b3 ? a4[i] : a4[i + 2], kp = b3 ? a4[i + 2] : a4[i]; a2[i] = kp + DPPF(snd, DPP_MIRROR); }
            float a1 = (b2 ? a2[1] : a2[0]) + DPPF(b2 ? a2[0] : a2[1], DPP_HMIRROR);
            a1 += DPPF(a1, DPP_XOR2); a1 += DPPF(a1, DPP_XOR1);
#pragma unroll
            for (int e = 0; e < 16; ++e) lg[e] = __builtin_bit_cast(float, __builtin_amdgcn_readlane(__builtin_bit_cast(int, a1), 4 * e));
        }
        float s[16], sb[16];
#pragma unroll
        for (int e = 0; e < 16; ++e) { s[e] = __builtin_amdgcn_rcpf(1.0f + __expf(-lg[e])); sb[e] = s[e] + rbias[e]; }
        int bg = 0; float bgs = -1e30f;
#pragma unroll
        for (int g = 0; g < 4; ++g) { float m1 = -1e30f, m2 = -1e30f;
#pragma unroll
            for (int k = 0; k < 4; ++k) { const float x = sb[4 * g + k]; if (x > m1) { m2 = m1; m1 = x; } else if (x > m2) m2 = x; }
            const float gs = m1 + m2; if (gs > bgs) { bgs = gs; bg = g; } }
        float gsb[4], gs_[4];
#pragma unroll
        for (int k = 0; k < 4; ++k) { gsb[k] = bg == 0 ? sb[k] : (bg == 1 ? sb[4 + k] : (bg == 2 ? sb[8 + k] : sb[12 + k])); gs_[k] = bg == 0 ? s[k] : (bg == 1 ? s[4 + k] : (bg == 2 ? s[8 + k] : s[12 + k])); }
        int i1 = 0; float b1 = gsb[0], s1 = gs_[0];
#pragma unroll
        for (int k = 1; k < 4; ++k) if (gsb[k] > b1) { b1 = gsb[k]; i1 = k; s1 = gs_[k]; }
        int i2 = -1; float b2 = -1e30f, s2 = 0.f;
#pragma unroll
        for (int k = 0; k < 4; ++k) if (k != i1 && gsb[k] > b2) { b2 = gsb[k]; i2 = k; s2 = gs_[k]; }
        if (F.lane == 0) {
            const int e0 = bg * 4 + i1, e1 = bg * 4 + i2;
            const int p0 = __hip_atomic_fetch_add(lcnt + e0, 1, __ATOMIC_RELAXED, __HIP_MEMORY_SCOPE_WORKGROUP);
            const int p1 = __hip_atomic_fetch_add(lcnt + e1, 1, __ATOMIC_RELAXED, __HIP_MEMORY_SCOPE_WORKGROUP);
            const float inv = 1.0f / (s1 + s2);
            LAS int* rr = lrow + ((r - F.gw) / F.NGW * NWAVES + F.wave) * 6; rr[0] = e0; rr[1] = e1; rr[2] = p0; rr[3] = p1; rr[4] = __builtin_bit_cast(int, s1 * inv); rr[5] = __builtin_bit_cast(int, s2 * inv);
        }
    }
    __syncthreads();
    if (F.tid < 16) lbase[F.tid] = (int)__hip_atomic_fetch_add(cnt + F.tid * 64, (unsigned)lcnt[F.tid], __ATOMIC_RELAXED, __HIP_MEMORY_SCOPE_AGENT);
    __syncthreads();
    if (F.tid < 72) { const int i = F.tid >> 3, w = F.tid & 7; const int r = F.bid * NWAVES + w + i * F.NGW;
        if (r < rows) { const LAS int* lr = lrow + F.tid * 6; int* rr = route + (size_t)r * 8;
            rr[0] = lr[0]; rr[1] = lr[1]; rr[2] = lbase[lr[0]] + lr[2]; rr[3] = lbase[lr[1]] + lr[3]; rr[4] = lr[4]; rr[5] = lr[5]; } }
}

__device__ __forceinline__ int expert_prefix(const Frame& F, int l, LAS int* ps) {
    const Args a = load_args(F.lds);
    const unsigned* cnt = (const unsigned*)(a.ws + WS_CTL) + CW_CNT + l * 16 * 64;
    __syncthreads();
    if (F.tid < 16) { const int c = (int)__hip_atomic_load(cnt + F.tid * 64, __ATOMIC_RELAXED, __HIP_MEMORY_SCOPE_AGENT); ps[40 + F.tid] = ((c + 255) >> 8) << 8; }
    __syncthreads();
    if (F.tid == 0) { int acc = 0; for (int e = 0; e < 16; ++e) { ps[e] = acc; acc += ps[40 + e]; } ps[16] = acc; }
    __syncthreads();
    return ps[16] >> 8;
}

__device__ __forceinline__ void phase_gather(const Frame& F, int l) {
    const Args a = load_args(F.lds);
    const bf16* H = (const bf16*)(a.ws + WS_H); bf16* XG = (bf16*)(a.ws + WS_XG);
    int* route = (int*)(a.ws + WS_ROUTE);
    LAS int* ps = (LAS int*)(F.lds + LDS_TILE_E);
    (void)expert_prefix(F, l, ps);
    const int rows = (l == 0) ? MA : ML;
#pragma unroll 1
    for (int r0 = F.gw; r0 < rows; r0 += 4 * F.NGW) {
        int d0[4], d1[4]; v4u x0[4], x1[4];
#pragma unroll
        for (int i = 0; i < 4; ++i) { const int r = r0 + i * F.NGW; if (r < rows) { const int4 rr = *(const int4*)(route + (size_t)r * 8); d0[i] = ps[rr.x] + rr.z; d1[i] = ps[rr.y] + rr.w;
            const v4u* src = (const v4u*)(H + (size_t)r * D); x0[i] = src[F.lane]; x1[i] = src[64 + F.lane]; } }
#pragma unroll
        for (int i = 0; i < 4; ++i) { const int r = r0 + i * F.NGW; if (r < rows) {
            v4u* o0 = (v4u*)(XG + (size_t)d0[i] * D); v4u* o1 = (v4u*)(XG + (size_t)d1[i] * D);
            o0[F.lane] = x0[i]; o0[64 + F.lane] = x1[i]; o1[F.lane] = x0[i]; o1[64 + F.lane] = x1[i];
            if (F.lane == 0) { int* rr = route + (size_t)r * 8; rr[6] = d0[i]; rr[7] = d1[i]; } } }
    }
}

__device__ __forceinline__ int moe_tiles(const Frame& F, int l) {
    LAS int* ps = (LAS int*)(F.lds + LDS_TILE_E); LAS int* te = ps + 64;
    const int T = expert_prefix(F, l, ps);
    for (int t = F.tid; t < T; t += NT) { int e = 0;
#pragma unroll
        for (int q = 1; q < 16; ++q) if ((ps[q] >> 8) <= t) e = q;
        te[t] = e; }
    __syncthreads();
    return T;
}

__device__ __forceinline__ void phase_combine(const Frame& F, int l) {
    const Args a = load_args(F.lds);
    const float* mod = (const float*)(a.ws + WS_MOD) + (size_t)l * 5 * 6144; bf16* H = (bf16*)(a.ws + WS_H);
    const float* ctxn = (const float*)(a.ws + WS_CTXN); const bf16* Y = (const bf16*)(a.ws + WS_Y);
    const int* route = (const int*)(a.ws + WS_ROUTE);
    const int rows = (l == 0) ? MA : ML;
#pragma unroll 1
    for (int r0 = F.gw; r0 < rows; r0 += 2 * F.NGW) {
        f32x4 xv[2][4]; v2u ya[2][4], yb[2][4]; float w0[2], w1[2];
#pragma unroll
        for (int i = 0; i < 2; ++i) { const int r = r0 + i * F.NGW; if (r < rows) {
            const float* src = (r < ML) ? a.out + (size_t)r * D : ctxn + (size_t)(r - ML) * D;
            const int4 ra = *(const int4*)(route + (size_t)r * 8 + 4);
            w0[i] = __builtin_bit_cast(float, ra.x); w1[i] = __builtin_bit_cast(float, ra.y);
            const bf16* y0 = Y + (size_t)ra.z * D; const bf16* y1 = Y + (size_t)ra.w * D;
#pragma unroll
            for (int q = 0; q < 4; ++q) { const int k = 4 * F.lane + 256 * q; xv[i][q] = *(const f32x4*)(src + k); ya[i][q] = *(const v2u*)(y0 + k); yb[i][q] = *(const v2u*)(y1 + k); } } }
#pragma unroll
        for (int i = 0; i < 2; ++i) { const int r = r0 + i * F.NGW; if (r < rows) {
            const bool lat = r < ML; const int j = lat ? (r >> 12) : 4;
            const float* g2 = mod + (size_t)j * 6144 + 5120;
            f32x4 v[4];
#pragma unroll
            for (int q = 0; q < 4; ++q) { const int k = 4 * F.lane + 256 * q;
                const f32x4 gg = *(const f32x4*)(g2 + k); const v2u a0 = ya[i][q], a1 = yb[i][q];
                f32x4 yy;
                yy.x = w0[i] * pg8::bf_lo(a0.x) + w1[i] * pg8::bf_lo(a1.x); yy.y = w0[i] * pg8::bf_hi(a0.x) + w1[i] * pg8::bf_hi(a1.x);
                yy.z = w0[i] * pg8::bf_lo(a0.y) + w1[i] * pg8::bf_lo(a1.y); yy.w = w0[i] * pg8::bf_hi(a0.y) + w1[i] * pg8::bf_hi(a1.y);
                v[q] = xv[i][q] + gg * yy;
                if (lat) *(f32x4*)(a.out + (size_t)r * D + k) = v[q]; }
            if (l == 0) { const float* m1 = (const float*)(a.ws + WS_MOD) + (size_t)(5 + j) * 6144;
                norm_mod_store(v, a.norm1_g + 1024, m1, m1 + 1024, H + (size_t)r * D, F.lane); } } }
    }
}

#define XB_TMO      128
#define XB_XCNT(j)  (256  + 64 * (j))
#define XB_XSUB(j)  (1280 + 64 * (j))
#define XB_XGEN(j)  (2304 + 64 * (j))
#define XB_TOP      3328
#define XB_TOPGEN   3392
#define XCD_BAR_WORDS 3456
#define XB_SPIN_CAP (1u << 18)
__device__ __forceinline__ unsigned xb_ld(unsigned* p)              { return __hip_atomic_load(p, __ATOMIC_RELAXED, __HIP_MEMORY_SCOPE_AGENT); }
__device__ __forceinline__ unsigned xb_add(unsigned* p, unsigned v) { return __hip_atomic_fetch_add(p, v, __ATOMIC_RELAXED, __HIP_MEMORY_SCOPE_AGENT); }
__device__ __forceinline__ unsigned xb_xcc_id() { return (unsigned)__builtin_amdgcn_s_getreg((3 << 11) | 20) & 0xFu; }
#define XB_SPIN(cond, bar) do { unsigned _sp = 0; while (cond) { __builtin_amdgcn_s_sleep(1); \
    if ((++_sp & 255u) == 0u) { if (xb_ld(&(bar)[XB_TMO])) break; if (_sp > XB_SPIN_CAP) { atomicAdd(&(bar)[XB_TMO], 1u); break; } } } } while (0)
struct XcdBarrier { unsigned* bar; unsigned x; volatile LAS unsigned* st; };
__device__ __forceinline__ XcdBarrier xcd_barrier_post(unsigned* bar, volatile LAS unsigned* st) {
    XcdBarrier b; b.bar = bar; b.x = xb_xcc_id(); b.st = st;
    if (threadIdx.x == 0) (void)xb_add(&bar[XB_XCNT(b.x)], 1u);
    return b;
}
__device__ __forceinline__ void xcd_barrier_complete(unsigned* bar, unsigned x, unsigned& nloc, unsigned& nx) {
    const unsigned G = gridDim.x * gridDim.y * gridDim.z;
    unsigned sum, cnt, mine, sp = 0u;
    for (;;) {
        sum = 0u; cnt = 0u; mine = 0u;
#pragma unroll
        for (unsigned j = 0; j < 16; ++j) { const unsigned c = xb_ld(&bar[XB_XCNT(j)]); sum += c; cnt += (c > 0u) ? 1u : 0u; mine = (j == x) ? c : mine; }
        if (sum == G) break;
        __builtin_amdgcn_s_sleep(1);
        if ((++sp & 255u) == 0u) { if (xb_ld(&bar[XB_TMO])) break; if (sp > XB_SPIN_CAP) { atomicAdd(&bar[XB_TMO], 1u); break; } }
    }
    nloc = mine > 0u ? mine : 1u; nx = cnt > 0u ? cnt : 1u;
}
__device__ __forceinline__ void xcd_barrier(const XcdBarrier& b) {
    asm volatile("s_waitcnt vmcnt(0)" ::: "memory");
    __syncthreads();
    if (threadIdx.x == 0) {
        unsigned* bar = b.bar;
        __builtin_amdgcn_s_waitcnt(0);
        unsigned nloc = b.st[0], nx = b.st[1];
        if (nloc == 0u) { xcd_barrier_complete(bar, b.x, nloc, nx); b.st[0] = nloc; b.st[1] = nx; }
        const unsigned old = xb_add(&bar[XB_XSUB(b.x)], 1u);
        const unsigned gen = old / nloc;
        if (old + 1u == (gen + 1u) * nloc) {
            __builtin_amdgcn_fence(__ATOMIC_RELEASE, "agent");
            asm volatile("s_waitcnt vmcnt(0)" ::: "memory");
            const unsigned og = xb_add(&bar[XB_TOP], 1u);
            const unsigned tg = og / nx;
            if (og + 1u == (tg + 1u) * nx) xb_add(&bar[XB_TOPGEN], 1u);
            else XB_SPIN(xb_ld(&bar[XB_TOPGEN]) == tg, bar);
            __builtin_amdgcn_fence(__ATOMIC_ACQUIRE, "agent");
            xb_add(&bar[XB_XGEN(b.x)], 1u);
            asm volatile("s_waitcnt vmcnt(0)" ::: "memory");
        } else {
            XB_SPIN(xb_ld(&bar[XB_XGEN(b.x)]) == gen, bar);
            __builtin_amdgcn_fence(__ATOMIC_ACQUIRE, "agent");
            asm volatile("s_waitcnt vmcnt(0)" ::: "memory");
        }
    }
    __syncthreads();
}

namespace pg8 {
enum { EM_PLAIN = 0, EM_IN = 1, EM_MERGE = 2, EM_OUT = 3, EM_MOE1 = 4 };
struct EpiAll {
    static constexpr bool PERM = true, AFTER_DRAIN = false;
    int mode, l, sub; LAS unsigned char* lds;
    __device__ __forceinline__ void operator()(const f32x4 (&acc)[2][2][4][2], const Unit& u, int wr, int wc, int fr, int fq) const {
        asm volatile("" : "+v"(fr), "+v"(fq));
        unsigned char* ws = (unsigned char*)(GAS unsigned char*)ldp(lds, 23);
        bf16* Hb = (bf16*)(ws + WS_H); bf16* Pb = (bf16*)(ws + WS_P);
        switch (mode) {
            case EM_PLAIN: { const EpiPlain e{(bf16*)(ws + WS_Y), D}; e(acc, u, wr, wc, fr, fq); } break;
            case EM_IN:    { const EpiIn e{Pb, INW, (const float*)(const GAS float*)ldp(lds, 8) + l * 64, (const float*)(const GAS float*)ldp(lds, 9) + l * 64, (const float2*)(ws + WS_ROPE), 64}; e(acc, u, wr, wc, fr, fq); } break;
            case EM_MERGE: { const EpiMerge e{Hb, Pb, INW, COL_G + sub * 1024, sub != 0 ? 1 : 0}; e(acc, u, wr, wc, fr, fq); } break;
            case EM_OUT:   { float* out = (float*)(GAS float*)ldp(lds, 22); const float* mod = (const float*)(ws + WS_MOD) + (size_t)l * 5 * 6144;
                             const EpiOut e{l == 0 ? (const float*)(const GAS float*)ldp(lds, 0) : (const float*)out, out, (const float*)(const GAS float*)ldp(lds, 2), (float*)(ws + WS_CTXN), mod + 2048}; e(acc, u, wr, wc, fr, fq); } break;
            default:       { const EpiMoe1 e{(bf16*)(ws + WS_ACT)}; e(acc, u, wr, wc, fr, fq); } break;
        }
    }
};
}

constexpr int N_PHASES = 2 + 9 * DEPTH;
#ifndef PROBE_MASK
#define PROBE_MASK 0
#endif
#ifndef FOURIER_SIMPLE
#define FOURIER_SIMPLE 0
#endif
#ifndef ATTN_SIMPLE
#define ATTN_SIMPLE 0
#endif
#ifndef REP_MASK
#define REP_MASK 0
#endif
__global__ void __launch_bounds__(NT, 2) __attribute__((amdgpu_waves_per_eu(2, 2))) mk_fwd(Args a) {
    extern __shared__ __attribute__((aligned(16))) unsigned char lds_raw[];
    LAS unsigned char* const lds0 = (LAS unsigned char*)lds_raw;
    volatile LAS unsigned* MISC = (volatile LAS unsigned*)(lds0 + LDS_MISC);
    if (threadIdx.x < 64) MISC[threadIdx.x] = 0u;
    if (threadIdx.x < 24) { const unsigned long long* ap = (const unsigned long long*)&a; ((LAS unsigned long long*)(lds0 + LDS_ATAB))[threadIdx.x] = ap[threadIdx.x]; }
    const int lo = a.ph_lo, hi = a.ph_hi;
    unsigned* barw = (unsigned*)(a.ws + WS_CTL) + CW_BAR;
    __syncthreads();
    XcdBarrier bar; bar.bar = barw; bar.x = 0; bar.st = nullptr;
    if (hi - lo > 1) bar = xcd_barrier_post(barw, MISC + 8);
    int ph = lo, sub = 0, rep_done = 0;
    unsigned long long probe_acc = 0ull, probe_t0 = 0ull;
#pragma unroll 1
    while (ph < hi) {
        int tid_o = threadIdx.x, bid_o = blockIdx.x, grid_o = gridDim.x;
        asm volatile("" : "+v"(tid_o)); asm volatile("" : "+s"(bid_o), "+s"(grid_o));
        Frame F;
        F.lds = lds0;
        F.tid = tid_o; F.lane = F.tid & 63; F.wave = __builtin_amdgcn_readfirstlane(F.tid >> 6);
        F.G = grid_o; F.bid = bid_o; F.gw = bid_o * NWAVES + F.wave; F.NGW = F.G * NWAVES;
        const int l = ph < 2 ? 0 : (ph - 2) / 9, k = ph < 2 ? -1 : (ph - 2) % 9;
        if (PROBE_MASK != 0 && sub == 0 && rep_done == 0) probe_t0 = __builtin_amdgcn_s_memrealtime();
        unsigned char* ws = (unsigned char*)(GAS unsigned char*)ldp(F.lds, 23);
        bool isg = false; int nsub = 1;
        pg8::Gemm g{nullptr, nullptr, 0, 0, 0}; pg8::Order S; S.init(1, 1, F.G, F.bid); pg8::EpiAll E{0, l, sub, F.lds};
        if (ph == 0) { for (int rp = 0; rp < 1 + ((REP_MASK >> 14) & 1); ++rp) phase_prologue(F); }
        else if (ph == 1) { for (int rp = 0; rp < 1 + ((REP_MASK >> 17) & 1); ++rp) phase_norm_a0(F); }
        else if (k == 0) {
            isg = true; g.A = (const bf16*)(ws + WS_H); g.Bt = (const bf16*)(ws + WS_WIN); g.K = D;
            S.init(l == 0 ? 68 : 64, 22, F.G, F.bid);
            if (l != 0) { S.exM0 = 64; S.exN = 4; S.exPn0 = 3; S.nExtra = 16; }
            E.mode = pg8::EM_IN;
        } else if (k == 1) {
            for (int rp = 0; rp < 1 + ((REP_MASK >> 15) & 1); ++rp) phase_conv(F, l);
            for (int rp = 0; rp < 1 + ((REP_MASK >> 12) & 1); ++rp) {
#if FOURIER_SIMPLE
                phase_fourier_simple(F, l, true);
#else
                phase_fourier_mfma(F, l); if (l == 0) phase_fourier_simple(F, l, false);
#endif
            }
            for (int rp = 0; rp < 1 + ((REP_MASK >> 13) & 1); ++rp) {
#if ATTN_SIMPLE
                phase_attn_simple(F, l);
#else
                phase_attn_mfma(F, l);
#endif
            } }
        else if (k == 2) {
            isg = true; nsub = 3; S.init(l == 0 ? 68 : 64, 4, F.G, F.bid);
            E.mode = pg8::EM_MERGE;
            if (sub == 0) { g.A = (const bf16*)(ws + WS_FY); g.Bt = (const bf16*)(ws + WS_WF); g.K = 512; }
            else if (sub == 1) { g.A = (const bf16*)(ws + WS_ATT); g.Bt = (const bf16*)(ws + WS_WNA); g.K = 512; }
            else { g.A = (const bf16*)(ws + WS_YCV); g.Bt = (const bf16*)(ws + WS_WCV); g.K = 256; }
        } else if (k == 3) {
            isg = true; S.init(l == 0 ? 68 : 64, 4, F.G, F.bid);
            g.A = (const bf16*)(ws + WS_H); g.Bt = (const bf16*)(ws + WS_WO); g.K = D;
            E.mode = pg8::EM_OUT;
        } else if (k == 4) phase_route(F, l);
        else if (k == 5) { for (int rp = 0; rp < 1 + ((REP_MASK >> 16) & 1); ++rp) phase_gather(F, l); }
        else if (k == 6 || k == 7) {
            isg = true; const int T = moe_tiles(F, l);
            S.moeUnits = T * 4; S.tile_e = (const LAS int*)(F.lds + LDS_TILE_E) + 64;
            if (k == 6) { g.A = (const bf16*)(ws + WS_XG); g.Bt = (const bf16*)(ws + WS_W13); g.K = D; E.mode = pg8::EM_MOE1; }
            else { g.A = (const bf16*)(ws + WS_ACT); g.Bt = (const bf16*)(ws + WS_W2); g.K = DE; E.mode = pg8::EM_PLAIN; }
        } else { phase_combine(F, l); if (l + 1 < DEPTH) { for (int rp = 0; rp < 1 + ((REP_MASK >> 18) & 1); ++rp) convert_weights(F, l + 1); } }
        if (isg) { const int nrep = (k >= 0 && ((REP_MASK >> k) & 1)) ? 2 : 1;
#pragma unroll 1
            for (int rp = 0; rp < nrep; ++rp) pg8::gemm_phase<pg8::EpiAll, pg8::Order, true, true>(F.lds, g, S, E); }
        if (sub + 1 < nsub) { ++sub; continue; }
        if (k >= 0 && ((REP_MASK >> (20 + k)) & 1) && !(k == 3 && l != 0) && rep_done == 0) { rep_done = 1; sub = 0; continue; }
        rep_done = 0; sub = 0; ++ph;
        if (ph < hi) { for (int rp = 0; rp < 1 + 4 * ((REP_MASK >> 19) & 1); ++rp) xcd_barrier(bar); }
        if (PROBE_MASK != 0) { const int pk = (ph - 1) < 2 ? (ph - 1) : 2 + ((ph - 1) - 2) % 9; if ((PROBE_MASK >> pk) & 1) probe_acc += __builtin_amdgcn_s_memrealtime() - probe_t0; }
    }
    if (PROBE_MASK != 0 && blockIdx.x == 0 && threadIdx.x == 0) { const unsigned long long t1 = __builtin_amdgcn_s_memrealtime(); while (__builtin_amdgcn_s_memrealtime() - t1 < 4ull * probe_acc) __builtin_amdgcn_s_sleep(8); }
}

#ifndef MK_SINGLE
#define MK_SINGLE 1
#endif
extern "C" void kernel_launch(void* const* d_in, const int* in_sizes, int n_in, void* d_out, int out_size, void* d_ws, size_t ws_size, hipStream_t stream) {
    static int grid = 0;
    if (grid == 0) {
        if (n_in != 22 || out_size != ML * D || ws_size < WS_END) { fprintf(stderr, "kernel_launch: unexpected shapes (n_in %d out %d ws %zu need %zu)\n", n_in, out_size, ws_size, (size_t)WS_END); grid = -1; return; }
        int dev = 0, cus = 0;
        if (hipGetDevice(&dev) != hipSuccess || hipDeviceGetAttribute(&cus, hipDeviceAttributeMultiprocessorCount, dev) != hipSuccess) { grid = -1; return; }
        if (hipFuncSetAttribute((const void*)mk_fwd, hipFuncAttributeMaxDynamicSharedMemorySize, LDS_BYTES) != hipSuccess) { fprintf(stderr, "kernel_launch: hipFuncSetAttribute failed\n"); grid = -1; return; }
        int per_cu = 0;
        if (hipOccupancyMaxActiveBlocksPerMultiprocessor(&per_cu, (const void*)mk_fwd, NT, LDS_BYTES) != hipSuccess || per_cu < 1) fprintf(stderr, "kernel_launch: occupancy query says %d\n", per_cu);
        (void)hipGetLastError();
        grid = cus;
    }
    if (grid < 0) return;
    (void)hipMemsetAsync((char*)d_ws + WS_CTL, 0, CTL_ZERO_BYTES, stream);
    Args a{};
    const float** ap = (const float**)&a;
    for (int i = 0; i < 22; ++i) ap[i] = (const float*)d_in[i];
    a.out = (float*)d_out; a.ws = (unsigned char*)d_ws;
#if MK_SINGLE
    a.ph_lo = 0; a.ph_hi = N_PHASES;
    hipLaunchKernelGGL(mk_fwd, dim3(grid), dim3(NT), LDS_BYTES, stream, a);
#else
    for (int p = 0; p < N_PHASES; ++p) { a.ph_lo = p; a.ph_hi = p + 1; hipLaunchKernelGGL(mk_fwd, dim3(grid), dim3(NT), LDS_BYTES, stream, a); }
#endif
}
```
